# Optimizing an MI355X kernel written in HIP

```python
import math
import jax, jax.numpy as jnp
from jax import lax
import numpy as np

D_MODEL = 2048
BATCH = 4
SEQ = 4096
DEPTH = 2

HEAD_DIM = 128
GRID_W = 64
BLOCK_Q = 128
RMS_EPS = 1e-6
NEG_INF = -1e30

T5_BUCKETS = 32
T5_MAX_DIST = 1024

DILATED_PATTERNS = ((128, 1), (512, 4), (2048, 16))
A_GROUPS = len(DILATED_PATTERNS)
A_HEADS = 8
B_HEADS = 4
B_QK_DIM = 128
B_V_DIM = 2 * B_QK_DIM
C_HEADS = 8
C_KV_HEADS = 2
ROPE_THETA = 10000.0
ROPE_AXIS_DIM = HEAD_DIM // 2
D_HEADS = 8
NA_ROWS = 8
NA_COLS = 16
D_FF = 5632
CONV_W = 3

N_T5_HEADS = A_GROUPS * A_HEADS + B_HEADS
EVEN_IN = A_GROUPS * 3 * A_HEADS * HEAD_DIM + B_HEADS * (4 * B_QK_DIM + B_V_DIM)
EVEN_OUT = A_HEADS * HEAD_DIM + B_HEADS * B_V_DIM
ODD_IN = (C_HEADS + 2 * C_KV_HEADS) * HEAD_DIM + 3 * D_HEADS * HEAD_DIM
ODD_OUT = (C_HEADS + D_HEADS) * HEAD_DIM

kernel_name = "hybrid_dilated_diff_axial_na_encoder"


def rmsnorm(x, gain):
    xf = x.astype(jnp.float32)
    y = xf * lax.rsqrt(jnp.mean(xf * xf, axis=-1, keepdims=True) + RMS_EPS)
    return (y * gain.astype(jnp.float32)).astype(x.dtype)


def t5_bucket(rel):
    nb = T5_BUCKETS // 2
    max_exact = nb // 2
    ret = jnp.where(rel > 0, nb, 0)
    n = jnp.abs(rel)
    n_f = jnp.maximum(n, 1).astype(jnp.float32)
    large = max_exact + (jnp.log(n_f / max_exact) / math.log(T5_MAX_DIST / max_exact)
                         * (nb - max_exact)).astype(jnp.int32)
    large = jnp.minimum(large, nb - 1)
    return ret + jnp.where(n < max_exact, n, large)


def query_blocks(q):
    b, s = q.shape[:2]
    nb = s // BLOCK_Q
    qb = jnp.moveaxis(q.reshape((b, nb, BLOCK_Q) + q.shape[2:]), 1, 0)
    return qb, jnp.arange(nb, dtype=jnp.int32) * BLOCK_Q


def merge_blocks(o):
    o = jnp.moveaxis(o, 0, 1)
    return o.reshape((o.shape[0], o.shape[1] * o.shape[2]) + o.shape[3:])


def dilated_window_attention(q, k, v, bias_cols, window, dilation):
    s = q.shape[1]
    half = window // (2 * dilation)
    offs = dilation * jnp.arange(-half, half + 1, dtype=jnp.int32)
    rel_bias = bias_cols[t5_bucket(offs)].T.astype(jnp.float32)
    scale = HEAD_DIM ** -0.5
    qb, starts = query_blocks(q)

    def block(args):
        qi, start = args
        pos = start + jnp.arange(BLOCK_Q, dtype=jnp.int32)
        idx = pos[:, None] + offs[None, :]
        valid = (idx >= 0) & (idx < s)
        idx = jnp.clip(idx, 0, s - 1)
        kg = k[:, idx]
        vg = v[:, idx]
        logits = (jnp.einsum("bqhd,bqkhd->bhqk", qi, kg).astype(jnp.float32) * scale
                  + rel_bias[None, :, None, :])
        logits = jnp.where(valid[None, None], logits, NEG_INF)
        m = jnp.max(logits, axis=-1, keepdims=True)
        p = jnp.exp(logits - m)
        denom = jnp.sum(p, axis=-1)
        o = (jnp.einsum("bhqk,bqkhd->bqhd", p, vg.astype(jnp.float32))
             / jnp.transpose(denom, (0, 2, 1))[..., None])
        lse = m[..., 0] + jnp.log(denom)
        return o, jnp.transpose(lse, (0, 2, 1))

    o, lse = lax.map(block, (qb, starts))
    return merge_blocks(o), merge_blocks(lse)


def differential_attention(q, k, v, bias_cols, lam):
    s = q.shape[1]
    scale = B_QK_DIM ** -0.5
    key_pos = jnp.arange(s, dtype=jnp.int32)
    vf = v.astype(jnp.float32)
    qb, starts = query_blocks(q)

    def block(args):
        qi, start = args
        pos = start + jnp.arange(BLOCK_Q, dtype=jnp.int32)
        bias = bias_cols[t5_bucket(key_pos[None, :] - pos[:, None])]
        bias = jnp.transpose(bias, (2, 0, 1)).astype(jnp.float32)
        logits = (jnp.einsum("bqhmd,bkhmd->bhmqk", qi, k).astype(jnp.float32) * scale
                  + bias[None, :, None])
        p = jax.nn.softmax(logits, axis=-1)
        w = p[:, :, 0] - lam * p[:, :, 1]
        return jnp.einsum("bhqk,bkhd->bqhd", w, vf)

    return merge_blocks(lax.map(block, (qb, starts)))


def axial_rope_tables(s):
    t = jnp.arange(s, dtype=jnp.int32)
    row = (t // GRID_W).astype(jnp.float32)
    col = (t % GRID_W).astype(jnp.float32)
    inv_freq = ROPE_THETA ** (-(jnp.arange(0, ROPE_AXIS_DIM, 2, dtype=jnp.float32) / ROPE_AXIS_DIM))
    ang = jnp.concatenate([row[:, None] * inv_freq[None], col[:, None] * inv_freq[None]], axis=-1)
    return jnp.cos(ang), jnp.sin(ang)


def apply_rope(x, cos, sin):
    xp = x.astype(jnp.float32).reshape(x.shape[:-1] + (HEAD_DIM // 2, 2))
    x0, x1 = xp[..., 0], xp[..., 1]
    c = cos[None, :, None, :]
    sn = sin[None, :, None, :]
    out = jnp.stack([x0 * c - x1 * sn, x0 * sn + x1 * c], axis=-1)
    return out.reshape(x.shape).astype(x.dtype)


def gqa_block_attention(q, k, v):
    b, s = q.shape[:2]
    g = C_HEADS // C_KV_HEADS
    scale = HEAD_DIM ** -0.5
    vf = v.astype(jnp.float32)
    qb, _ = query_blocks(q.reshape(b, s, C_KV_HEADS, g, HEAD_DIM))

    def block(qi):
        logits = jnp.einsum("bqngd,bknd->bngqk", qi, k).astype(jnp.float32) * scale
        p = jax.nn.softmax(logits, axis=-1)
        return jnp.einsum("bngqk,bknd->bqngd", p, vf)

    o = merge_blocks(lax.map(block, qb))
    return o.reshape(b, s, C_HEADS * HEAD_DIM)


def neighbourhood_attention(q, k, v, rpb, rows):
    b, s, h, dh = q.shape
    kr = min(NA_ROWS, rows)
    kc = NA_COLS
    scale = dh ** -0.5
    kg = k.reshape(b, rows, GRID_W, h, dh)
    vg = v.reshape(b, rows, GRID_W, h, dh)
    qrows = jnp.moveaxis(q.reshape(b, rows, GRID_W, h, dh), 1, 0)
    cols = jnp.arange(GRID_W, dtype=jnp.int32)
    col_start = jnp.clip(cols - kc // 2, 0, GRID_W - kc)
    col_idx = col_start[:, None] + jnp.arange(kc, dtype=jnp.int32)[None, :]
    dc = col_idx - cols[:, None] + (NA_COLS - 1)

    def row(args):
        qi, i = args
        rs = jnp.clip(i - kr // 2, 0, rows - kr)
        kband = lax.dynamic_slice_in_dim(kg, rs, kr, axis=1)
        vband = lax.dynamic_slice_in_dim(vg, rs, kr, axis=1)
        kq = kband[:, :, col_idx]
        vq = vband[:, :, col_idx]
        dr = rs + jnp.arange(kr, dtype=jnp.int32) - i + (NA_ROWS - 1)
        bias = rpb[:, dr][:, :, dc]
        bias = jnp.transpose(bias, (0, 2, 1, 3)).astype(jnp.float32)
        logits = (jnp.einsum("bjhd,brjchd->bhjrc", qi, kq).astype(jnp.float32) * scale
                  + bias[None])
        p = jax.nn.softmax(logits.reshape(b, h, GRID_W, kr * kc), axis=-1).reshape(b, h, GRID_W, kr, kc)
        return jnp.einsum("bhjrc,brjchd->bjhd", p, vq.astype(jnp.float32))

    o = lax.map(row, (qrows, jnp.arange(rows, dtype=jnp.int32)))
    return jnp.moveaxis(o, 0, 1).reshape(b, s, h * dh)


def even_mixer(y, w_in, w_out, lq1, lk1, lq2, lk2, subln, t5_table, lambda_init):
    b, s, _ = y.shape
    proj = jnp.einsum("bsd,de->bse", y, w_in)
    a_cols = A_GROUPS * 3 * A_HEADS * HEAD_DIM
    pa = proj[..., :a_cols].reshape(b, s, A_GROUPS, 3, A_HEADS, HEAD_DIM)
    outs, lses = [], []
    for gi, (window, dilation) in enumerate(DILATED_PATTERNS):
        cols = t5_table[:, gi * A_HEADS:(gi + 1) * A_HEADS]
        o, lse = dilated_window_attention(pa[:, :, gi, 0], pa[:, :, gi, 1], pa[:, :, gi, 2],
                                          cols, window, dilation)
        outs.append(o)
        lses.append(lse)
    alpha = jax.nn.softmax(jnp.stack(lses), axis=0)[..., None]
    out_a = jnp.sum(alpha * jnp.stack(outs), axis=0).reshape(b, s, A_HEADS * HEAD_DIM)

    pb = proj[..., a_cols:]
    qk_cols = B_HEADS * 2 * B_QK_DIM
    q_b = pb[..., :qk_cols].reshape(b, s, B_HEADS, 2, B_QK_DIM)
    k_b = pb[..., qk_cols:2 * qk_cols].reshape(b, s, B_HEADS, 2, B_QK_DIM)
    v_b = pb[..., 2 * qk_cols:].reshape(b, s, B_HEADS, B_V_DIM)
    f32 = jnp.float32
    lam = (jnp.exp(jnp.sum(lq1.astype(f32) * lk1.astype(f32)))
           - jnp.exp(jnp.sum(lq2.astype(f32) * lk2.astype(f32))) + lambda_init)
    o_b = differential_attention(q_b, k_b, v_b, t5_table[:, A_GROUPS * A_HEADS:], lam)
    o_b = rmsnorm(o_b, subln) * (1.0 - lambda_init)
    out_b = o_b.reshape(b, s, B_HEADS * B_V_DIM)
    mixed = jnp.concatenate([out_a, out_b], axis=-1).astype(y.dtype)
    return jnp.einsum("bse,ed->bsd", mixed, w_out)


def odd_mixer(y, w_in, w_out, q_norm, k_norm, rpb, rows):
    b, s, _ = y.shape
    proj = jnp.einsum("bsd,de->bse", y, w_in)
    nq = C_HEADS * HEAD_DIM
    nkv = C_KV_HEADS * HEAD_DIM
    q_c = proj[..., :nq].reshape(b, s, C_HEADS, HEAD_DIM)
    k_c = proj[..., nq:nq + nkv].reshape(b, s, C_KV_HEADS, HEAD_DIM)
    v_c = proj[..., nq + nkv:nq + 2 * nkv].reshape(b, s, C_KV_HEADS, HEAD_DIM)
    pd = proj[..., nq + 2 * nkv:].reshape(b, s, 3, D_HEADS, HEAD_DIM)
    cos, sin = axial_rope_tables(s)
    q_c = apply_rope(rmsnorm(q_c, q_norm), cos, sin)
    k_c = apply_rope(rmsnorm(k_c, k_norm), cos, sin)
    o_c = gqa_block_attention(q_c, k_c, v_c)
    o_d = neighbourhood_attention(pd[:, :, 0], pd[:, :, 1], pd[:, :, 2], rpb, rows)
    mixed = jnp.concatenate([o_c, o_d], axis=-1).astype(y.dtype)
    return jnp.einsum("bse,ed->bsd", mixed, w_out)


def conv_ffn(x, w_up, conv_w, conv_b, w_down):
    h = jnp.einsum("bsd,df->bsf", x, w_up)
    g, u = h[..., :D_FF], h[..., D_FF:]
    gp = jnp.pad(g, ((0, 0), (1, 1), (0, 0)))
    g = conv_w[0] * gp[:, :-2] + conv_w[1] * gp[:, 1:-1] + conv_w[2] * gp[:, 2:] + conv_b
    return jnp.einsum("bsf,fd->bsd", jax.nn.gelu(g) * u, w_down)


def setup_inputs(seed: int = 0) -> dict:
    key = jax.random.key(seed)
    ks = jax.random.split(key, 21)
    ne, no = (DEPTH + 1) // 2, DEPTH // 2
    f32 = jnp.float32

    def w(k, shape, fan_in):
        return jax.random.normal(k, shape, f32) * fan_in ** -0.5

    def gain(k, shape):
        return 1.0 + 0.1 * jax.random.normal(k, shape, f32)

    return {
        "x": jax.random.normal(ks[0], (BATCH, SEQ, D_MODEL), f32),
        "ln_mix": gain(ks[1], (DEPTH, D_MODEL)),
        "ln_ffn": gain(ks[2], (DEPTH, D_MODEL)),
        "ln_final": gain(ks[3], (D_MODEL,)),
        "t5_table": 0.5 * jax.random.normal(ks[4], (T5_BUCKETS, N_T5_HEADS), f32),
        "ev_w_in": w(ks[5], (ne, D_MODEL, EVEN_IN), D_MODEL),
        "ev_w_out": w(ks[6], (ne, EVEN_OUT, D_MODEL), EVEN_OUT),
        "diff_lq1": 0.1 * jax.random.normal(ks[7], (ne, B_QK_DIM), f32),
        "diff_lk1": 0.1 * jax.random.normal(ks[8], (ne, B_QK_DIM), f32),
        "diff_lq2": 0.1 * jax.random.normal(ks[9], (ne, B_QK_DIM), f32),
        "diff_lk2": 0.1 * jax.random.normal(ks[10], (ne, B_QK_DIM), f32),
        "diff_subln": gain(ks[11], (ne, B_V_DIM)),
        "od_w_in": w(ks[12], (no, D_MODEL, ODD_IN), D_MODEL),
        "od_w_out": w(ks[13], (no, ODD_OUT, D_MODEL), ODD_OUT),
        "gqa_q_norm": gain(ks[14], (no, HEAD_DIM)),
        "gqa_k_norm": gain(ks[15], (no, HEAD_DIM)),
        "na_rpb": 0.5 * jax.random.normal(ks[16], (no, D_HEADS, 2 * NA_ROWS - 1, 2 * NA_COLS - 1), f32),
        "ffn_w_up": w(ks[17], (DEPTH, D_MODEL, 2 * D_FF), D_MODEL),
        "ffn_conv_w": jax.random.normal(ks[18], (DEPTH, CONV_W, D_FF), f32) * CONV_W ** -0.5,
        "ffn_conv_b": 0.02 * jax.random.normal(ks[19], (DEPTH, D_FF), f32),
        "ffn_w_down": w(ks[20], (DEPTH, D_FF, D_MODEL), D_FF),
    }


def reference(x, ln_mix, ln_ffn, ln_final, t5_table, ev_w_in, ev_w_out, diff_lq1, diff_lk1,
              diff_lq2, diff_lk2, diff_subln, od_w_in, od_w_out, gqa_q_norm, gqa_k_norm, na_rpb,
              ffn_w_up, ffn_conv_w, ffn_conv_b, ffn_w_down):
    rows = x.shape[1] // GRID_W
    h = x
    for layer in range(DEPTH):
        y = rmsnorm(h, ln_mix[layer])
        if layer % 2 == 0:
            e = layer // 2
            lambda_init = 0.8 - 0.6 * math.exp(-0.3 * layer)
            mix = even_mixer(y, ev_w_in[e], ev_w_out[e], diff_lq1[e], diff_lk1[e], diff_lq2[e],
                             diff_lk2[e], diff_subln[e], t5_table, lambda_init)
        else:
            o = layer // 2
            mix = odd_mixer(y, od_w_in[o], od_w_out[o], gqa_q_norm[o], gqa_k_norm[o], na_rpb[o], rows)
        h = h + mix.astype(h.dtype)
        f = conv_ffn(rmsnorm(h, ln_ffn[layer]), ffn_w_up[layer], ffn_conv_w[layer],
                     ffn_conv_b[layer], ffn_w_down[layer])
        h = h + f.astype(h.dtype)
    return rmsnorm(h, ln_final)
```

```cpp
#include <hip/hip_runtime.h>
#include <hip/hip_cooperative_groups.h>
#include <cstdio>
#include <cstdint>
namespace cg = cooperative_groups;

#ifndef MK_PER_PHASE
#define MK_PER_PHASE 0
#endif

#ifndef ATT_EN
#define ATT_EN 15
#endif
#define LAS __attribute__((address_space(3)))
#define GAS __attribute__((address_space(1)))
typedef const __attribute__((address_space(1))) float* gfp;
typedef unsigned short bf16_t;
typedef short bf16x8 __attribute__((ext_vector_type(8)));
typedef short s16x4 __attribute__((ext_vector_type(4)));
typedef float f32x4 __attribute__((ext_vector_type(4)));
typedef float f32x2 __attribute__((ext_vector_type(2)));
typedef float f32x16 __attribute__((ext_vector_type(16)));
typedef unsigned u32x4 __attribute__((ext_vector_type(4)));
typedef unsigned u32x2 __attribute__((ext_vector_type(2)));

constexpr int MT = 16384, SEQ = 4096, DM = 2048, NBATCH = 4;
constexpr int EV_IN = 12288, OD_IN = 4608, DFF = 5632, DFF2 = 11264;
constexpr int EV_LD = EV_IN + 64;
constexpr float RMS_EPS = 1e-6f;
constexpr float ATT_SCALE = 0.088388347648318440f;
constexpr int NWAVES = 8, NTHREADS = 512;
constexpr int LDS_BYTES = 147456;
constexpr int NPHASES = 16;

constexpr size_t MiB = 1u << 20;
constexpr size_t WS_SS = 0;
constexpr size_t WS_BAR = 384 * 1024;
constexpr size_t WS_TAB = 512 * 1024;
constexpr size_t WS_LSE = 1 * MiB;
constexpr size_t WS_LUT1 = 3 * MiB;
constexpr size_t WS_LUT2 = WS_LUT1 + 4 * 8192 * 4;
constexpr size_t WS_LUT3 = WS_LUT2 + 24 * 1024 * 4;
constexpr size_t WS_WIN = 4 * MiB;
constexpr size_t WS_WOUT = 52 * MiB;
constexpr size_t WS_WUP = 60 * MiB;
constexpr size_t WS_WDN = 104 * MiB;
constexpr size_t WS_R1 = 126 * MiB;
constexpr size_t WS_R2 = 190 * MiB;
constexpr size_t WS_BIG = 254 * MiB;
constexpr size_t WS_END = 642 * MiB;

__device__ __forceinline__ unsigned f2bf(float f) { unsigned u = __builtin_bit_cast(unsigned, f); return (u + 0x7fffu + ((u >> 16) & 1u)) >> 16; }
__device__ __forceinline__ unsigned cvt_pk_bf16(float lo, float hi) { unsigned r; asm volatile("v_cvt_pk_bf16_f32 %0, %1, %2" : "=v"(r) : "v"(lo), "v"(hi)); return r; }
__device__ __forceinline__ float bf_lo(unsigned w) { return __builtin_bit_cast(float, w << 16); }
__device__ __forceinline__ float bf_hi(unsigned w) { return __builtin_bit_cast(float, w & 0xffff0000u); }
__device__ __forceinline__ float wave_sum(float v) {
#pragma unroll
    for (int o = 1; o < 64; o <<= 1) v += __shfl_xor(v, o);
    return v;
}
__device__ __forceinline__ int ltid_(int wave0) { int z = 0; asm volatile("" : "+v"(z)); return wave0 * 64 + (int)__builtin_amdgcn_mbcnt_hi(~0u, __builtin_amdgcn_mbcnt_lo(~0u, (unsigned)z)); }
#define ltid() ltid_(wave0)
__device__ __forceinline__ gfp uni_ptr(gfp p) { const unsigned long long v = (unsigned long long)p; const unsigned lo = __builtin_amdgcn_readfirstlane((unsigned)v), hi = __builtin_amdgcn_readfirstlane((unsigned)(v >> 32)); return (gfp)(((unsigned long long)hi << 32) | lo); }
__device__ __forceinline__ unsigned dpp_xor1(unsigned v) { return (unsigned)__builtin_amdgcn_update_dpp(0, (int)v, 0xB1, 0xf, 0xf, false); }
__device__ __forceinline__ float dpp_xor1(float v) { return __int_as_float(__builtin_amdgcn_update_dpp(0, __float_as_int(v), 0xB1, 0xf, 0xf, false)); }
#define LDS_WAIT() asm volatile("s_waitcnt lgkmcnt(0)" ::: "memory")

__device__ __forceinline__ float gelu_tanh(float x) {
    constexpr float C1 = -2.0f * 1.4426950408889634f * 0.7978845608028654f, C2 = C1 * 0.044715f;
    const float e = __builtin_amdgcn_exp2f(x * fmaf(x * x, C2, C1));
    return x * __builtin_amdgcn_rcpf(1.0f + e);
}


namespace pg8 {
constexpr int BM = 256, BK = 64, HALF = 128, HTB = HALF * BK * 2, STAGE_BYTES = 8 * HTB, NXCD = 8, WGM = 8;
__host__ __device__ __forceinline__ int lds_byte(int r, int c) { const int st = (r >> 4) * 2 + (c >> 5), rr = r & 15, cc = c & 31, ob = rr * 64 + cc * 2; return st * 1024 + (ob ^ (((ob >> 9) & 1) << 5)); }
__host__ __device__ __forceinline__ void stage_rc(int b, int& R, int& C) { const int st = b / 1024, sb = b % 1024, swz = sb ^ (((sb >> 9) & 1) << 5); R = (st >> 1) * 16 + swz / 64; C = (st & 1) * 32 + (swz % 64) / 2; }
__host__ __device__ __forceinline__ int perm32(int rho) { const int n = rho >> 4, i = rho & 15; return 8 * (i >> 2) + 4 * n + (i & 3); }

struct Unit { int pm, pn; };
struct Gemm { const bf16_t* A; const bf16_t* Bt; int M, N, K, lda; };

struct StaticOrder {
    int nM, nN, nwg, G, c;
    __device__ __forceinline__ void init(int M, int N, int G_, int c_) { nM = M / BM; nN = N / BM; nwg = nM * nN; G = G_; c = c_; }
    __device__ __forceinline__ bool next(int i, Unit& u) const {
        const long L = (long)i * G + c; if (L >= nwg) return false;
        int wgid = (int)L; { const int q = nwg / NXCD, r = nwg % NXCD, xcd = wgid % NXCD, off = wgid / NXCD; wgid = (xcd < r ? xcd * (q + 1) : r * (q + 1) + (xcd - r) * q) + off; }
        const int nig = WGM * nN, gid = wgid / nig, fm = gid * WGM, gsz = (nM - fm) < WGM ? (nM - fm) : WGM;
        u.pm = fm + ((wgid % nig) % gsz); u.pn = (wgid % nig) / gsz; return true;
    }
};

__device__ __forceinline__ void store_pair_rows(bf16_t* O, size_t ldc, int row, int col0, int fr, u32x4 p0, u32x4 p1) {
    const bool odd = (fr & 1) != 0;
    const u32x4 snd = odd ? p0 : p1; u32x4 rcv;
    rcv.x = dpp_xor1(snd.x); rcv.y = dpp_xor1(snd.y); rcv.z = dpp_xor1(snd.z); rcv.w = dpp_xor1(snd.w);
    bf16_t* pa = O + (size_t)(row - (odd ? 1 : 0)) * ldc + col0 + (odd ? 8 : 0);
    *(u32x4*)pa = odd ? rcv : p0;
    *(u32x4*)(pa + ldc) = odd ? p1 : rcv;
}
template <bool SCALE>
struct EpiScaleBf16 {
    static constexpr int MAP = 2;
    bf16_t* O; int ldc; const float* ss; LAS float* RS;
    __device__ __forceinline__ void operator()(const f32x4 (&acc)[2][2][4][2], const Unit& u, int wr, int wc, int fr, int fq) const {
        if constexpr (SCALE) {
            const int tid = (wr * 4 + wc) * 64 + fq * 16 + fr;
            if (tid < 256) RS[tid] = __builtin_amdgcn_rsqf(ss[u.pm * BM + tid] * (1.0f / DM) + RMS_EPS);
            asm volatile("s_waitcnt vmcnt(0) lgkmcnt(0)" ::: "memory"); __builtin_amdgcn_s_barrier(); asm volatile("" ::: "memory");
        }
        const int lr0 = wr * 64 + fr, row0 = u.pm * BM + lr0, col0 = u.pn * BM + wc * 64 + 16 * fq;
#pragma unroll
        for (int ai = 0; ai < 2; ++ai)
#pragma unroll
            for (int m = 0; m < 4; ++m) {
                const int row = row0 + ai * HALF + m * 16;
                float rs = 1.0f; if constexpr (SCALE) rs = RS[lr0 + ai * HALF + m * 16];
                u32x4 pw[2];
#pragma unroll
                for (int bj = 0; bj < 2; ++bj) { const f32x4 v0 = acc[ai][bj][m][0] * rs, v1 = acc[ai][bj][m][1] * rs;
                    pw[bj].x = cvt_pk_bf16(v0[0], v0[1]); pw[bj].y = cvt_pk_bf16(v0[2], v0[3]); pw[bj].z = cvt_pk_bf16(v1[0], v1[1]); pw[bj].w = cvt_pk_bf16(v1[2], v1[3]); }
                store_pair_rows(O, (size_t)ldc, row, col0, fr, pw[0], pw[1]);
            }
    }
};
struct EpiScaleRope {
    static constexpr int MAP = 2;
    bf16_t* O; int ldc; const float* ss; LAS float* RS; LAS float* PS; gfp qn; gfp kn;
    __device__ __forceinline__ void operator()(f32x4 (&acc)[2][2][4][2], const Unit& u, int wr, int wc, int fr_in, int fq_in) const {
        (void)fr_in; (void)fq_in; int z_ = 0; asm volatile("" : "+v"(z_));
        const int lane_ = (int)__builtin_amdgcn_mbcnt_hi(~0u, __builtin_amdgcn_mbcnt_lo(~0u, (unsigned)z_)), fr = lane_ & 15, fq = lane_ >> 4;
        const int tid = (wr * 4 + wc) * 64 + fq * 16 + fr;
        if (tid < 256) RS[tid] = __builtin_amdgcn_rsqf(ss[u.pm * BM + tid] * (1.0f / DM) + RMS_EPS);
        asm volatile("s_waitcnt vmcnt(0) lgkmcnt(0)" ::: "memory"); __builtin_amdgcn_s_barrier(); asm volatile("" ::: "memory");
        const int lr0 = wr * 64 + fr, row0 = u.pm * BM + lr0, col0 = u.pn * BM + wc * 64 + 16 * fq;
#pragma unroll
        for (int ai = 0; ai < 2; ++ai)
#pragma unroll
            for (int m = 0; m < 4; ++m) { const float rs = RS[lr0 + ai * HALF + m * 16];
#pragma unroll
                for (int bj = 0; bj < 2; ++bj)
#pragma unroll
                    for (int n = 0; n < 2; ++n) acc[ai][bj][m][n] *= rs; }
        if (u.pn < 5) {
#pragma unroll
            for (int ai = 0; ai < 2; ++ai)
#pragma unroll
                for (int m = 0; m < 4; ++m) { float s = 0.f;
#pragma unroll
                    for (int bj = 0; bj < 2; ++bj)
#pragma unroll
                        for (int n = 0; n < 2; ++n) { const f32x4 v = acc[ai][bj][m][n]; s += (v[0] * v[0] + v[1] * v[1]) + (v[2] * v[2] + v[3] * v[3]); }
                    s += __shfl_xor(s, 16); s += __shfl_xor(s, 32);
                    if (fq == 0) PS[(lr0 + ai * HALF + m * 16) * 4 + wc] = s; }
            asm volatile("s_waitcnt lgkmcnt(0)" ::: "memory"); __builtin_amdgcn_s_barrier(); asm volatile("" ::: "memory");
            const gfp gsrc = (u.pn < 4) ? qn : kn; const int dbase = 64 * (wc & 1) + 16 * fq;
            f32x4 gg[2][2]; float invf[2][2][2];
#pragma unroll
            for (int bj = 0; bj < 2; ++bj)
#pragma unroll
                for (int n = 0; n < 2; ++n) { gg[bj][n] = *(const GAS f32x4*)(gsrc + dbase + 8 * bj + 4 * n);
#pragma unroll
                    for (int h = 0; h < 2; ++h) invf[bj][n][h] = __builtin_amdgcn_exp2f(-(float)(2 * (8 * fq + 4 * bj + 2 * n + h)) * (13.287712379549449f / 64.0f)); }
            const bool colaxis = (wc & 1) != 0;
#pragma unroll
            for (int ai = 0; ai < 2; ++ai)
#pragma unroll
                for (int m = 0; m < 4; ++m) { const int lr = lr0 + ai * HALF + m * 16;
                    const float tot = PS[lr * 4 + wc] + PS[lr * 4 + (wc ^ 1)]; const float r2 = __builtin_amdgcn_rsqf(tot * (1.0f / 128.0f) + RMS_EPS);
                    const int t = (row0 + ai * HALF + m * 16) & (SEQ - 1); const float pos = colaxis ? (float)(t & 63) : (float)(t >> 6);
                    u32x4 pw[2];
#pragma unroll
                    for (int bj = 0; bj < 2; ++bj) {
#pragma unroll
                        for (int n = 0; n < 2; ++n) { f32x4 v = acc[ai][bj][m][n] * r2 * gg[bj][n];
#pragma unroll
                            for (int h = 0; h < 2; ++h) { const float rev = pos * invf[bj][n][h] * 0.15915494309189535f; const float sn = __builtin_amdgcn_sinf(rev), cs = __builtin_amdgcn_cosf(rev); const float x0 = v[2 * h], x1 = v[2 * h + 1];
                                pw[bj][2 * n + h] = cvt_pk_bf16(x0 * cs - x1 * sn, x0 * sn + x1 * cs); } } }
                    store_pair_rows(O, (size_t)ldc, row0 + ai * HALF + m * 16, col0, fr, pw[0], pw[1]);
                    asm volatile("" ::: "memory"); }
        } else {
#pragma unroll
        for (int ai = 0; ai < 2; ++ai)
#pragma unroll
            for (int m = 0; m < 4; ++m) { u32x4 pw[2];
#pragma unroll
                for (int bj = 0; bj < 2; ++bj) { const f32x4 v0 = acc[ai][bj][m][0], v1 = acc[ai][bj][m][1];
                    pw[bj].x = cvt_pk_bf16(v0[0], v0[1]); pw[bj].y = cvt_pk_bf16(v0[2], v0[3]); pw[bj].z = cvt_pk_bf16(v1[0], v1[1]); pw[bj].w = cvt_pk_bf16(v1[2], v1[3]); }
                store_pair_rows(O, (size_t)ldc, row0 + ai * HALF + m * 16, col0, fr, pw[0], pw[1]); }
        }
    }
};
template <bool BASE_F32, bool OUT_F32>
struct EpiResid {
    static constexpr bool ALLBF = !BASE_F32 && !OUT_F32;
    static constexpr int MAP = ALLBF ? 2 : 1;
    gfp basef; const bf16_t* baseb; float* H; bf16_t* HB; float* ssn;
    __device__ __forceinline__ void operator()(const f32x4 (&acc)[2][2][4][2], const Unit& u, int wr, int wc, int fr, int fq) const {
        if constexpr (ALLBF) {
            const int row0 = u.pm * BM + wr * 64 + fr, col0 = u.pn * BM + wc * 64 + 16 * fq; const bool odd = (fr & 1) != 0;
#pragma unroll
            for (int ai = 0; ai < 2; ++ai)
#pragma unroll
                for (int m = 0; m < 4; ++m) {
                    const int row = row0 + ai * HALF + m * 16; float s = 0.f;
                    const bf16_t* pa = baseb + (size_t)(row - (odd ? 1 : 0)) * DM + col0 + (odd ? 8 : 0);
                    const u32x4 la = *(const u32x4*)pa, lb = *(const u32x4*)(pa + DM);
                    const u32x4 snd = odd ? la : lb; u32x4 rcv;
                    rcv.x = dpp_xor1(snd.x); rcv.y = dpp_xor1(snd.y); rcv.z = dpp_xor1(snd.z); rcv.w = dpp_xor1(snd.w);
                    const u32x4 bw0 = odd ? rcv : la, bw1 = odd ? lb : rcv;
                    u32x4 pw[2];
#pragma unroll
                    for (int bj = 0; bj < 2; ++bj) { const u32x4 bw = bj ? bw1 : bw0;
                        const f32x4 b0 = (f32x4){bf_lo(bw.x), bf_hi(bw.x), bf_lo(bw.y), bf_hi(bw.y)}, b1 = (f32x4){bf_lo(bw.z), bf_hi(bw.z), bf_lo(bw.w), bf_hi(bw.w)};
                        const f32x4 v0 = acc[ai][bj][m][0] + b0, v1 = acc[ai][bj][m][1] + b1;
                        pw[bj].x = cvt_pk_bf16(v0[0], v0[1]); pw[bj].y = cvt_pk_bf16(v0[2], v0[3]); pw[bj].z = cvt_pk_bf16(v1[0], v1[1]); pw[bj].w = cvt_pk_bf16(v1[2], v1[3]);
                        s += (v0[0] * v0[0] + v0[1] * v0[1]) + (v0[2] * v0[2] + v0[3] * v0[3]) + (v1[0] * v1[0] + v1[1] * v1[1]) + (v1[2] * v1[2] + v1[3] * v1[3]); }
                    store_pair_rows(HB, (size_t)DM, row, col0, fr, pw[0], pw[1]);
                    s += __shfl_xor(s, 16); s += __shfl_xor(s, 32);
                    if (fq == 0) unsafeAtomicAdd(ssn + row, s);
                }
        } else {
        const int row0 = u.pm * BM + wr * 64 + fr, col0 = u.pn * BM + wc * 32 + 8 * fq; const bool odd = (fr & 1) != 0;
#pragma unroll
        for (int ai = 0; ai < 2; ++ai)
#pragma unroll
            for (int m = 0; m < 4; ++m) {
                const int row = row0 + ai * HALF + m * 16; float s = 0.f;
                const size_t off = (size_t)row * DM + col0;
                const size_t offp = (size_t)(row - (odd ? 1 : 0)) * DM + col0 + (odd ? 4 : 0);
#pragma unroll
                for (int bj = 0; bj < 2; ++bj) {
                    f32x4 b0, b1;
                    if constexpr (BASE_F32) { const f32x4 la = *(const GAS f32x4*)(basef + offp + bj * HALF), lb = *(const GAS f32x4*)(basef + offp + DM + bj * HALF);
                        const f32x4 snd = odd ? la : lb; f32x4 rcv; rcv[0] = dpp_xor1(snd[0]); rcv[1] = dpp_xor1(snd[1]); rcv[2] = dpp_xor1(snd[2]); rcv[3] = dpp_xor1(snd[3]);
                        b0 = odd ? rcv : la; b1 = odd ? lb : rcv; }
                    else { const u32x4 bw = *(const u32x4*)(baseb + off + bj * HALF);
                        b0 = (f32x4){bf_lo(bw.x), bf_hi(bw.x), bf_lo(bw.y), bf_hi(bw.y)}; b1 = (f32x4){bf_lo(bw.z), bf_hi(bw.z), bf_lo(bw.w), bf_hi(bw.w)}; }
                    const f32x4 v0 = acc[ai][bj][m][0] + b0, v1 = acc[ai][bj][m][1] + b1;
                    if constexpr (OUT_F32) { const f32x4 snd = odd ? v0 : v1; f32x4 rcv; rcv[0] = dpp_xor1(snd[0]); rcv[1] = dpp_xor1(snd[1]); rcv[2] = dpp_xor1(snd[2]); rcv[3] = dpp_xor1(snd[3]);
                        *(f32x4*)(H + offp + bj * HALF) = odd ? rcv : v0; *(f32x4*)(H + offp + DM + bj * HALF) = odd ? v1 : rcv; }
                    else { u32x4 w; w.x = cvt_pk_bf16(v0[0], v0[1]); w.y = cvt_pk_bf16(v0[2], v0[3]); w.z = cvt_pk_bf16(v1[0], v1[1]); w.w = cvt_pk_bf16(v1[2], v1[3]);
                        *(u32x4*)(HB + off + bj * HALF) = w; }
                    s += (v0[0] * v0[0] + v0[1] * v0[1]) + (v0[2] * v0[2] + v0[3] * v0[3]) + (v1[0] * v1[0] + v1[1] * v1[1]) + (v1[2] * v1[2] + v1[3] * v1[3]);
                }
                s += __shfl_xor(s, 16); s += __shfl_xor(s, 32);
                if (fq == 0) unsafeAtomicAdd(ssn + row, s);
            }
        }
    }
};
__device__ __forceinline__ float dpp_ror1(float v) { return __int_as_float(__builtin_amdgcn_update_dpp(0, __float_as_int(v), 0x121, 0xf, 0xf, false)); }
__device__ __forceinline__ float dpp_rol1(float v) { return __int_as_float(__builtin_amdgcn_update_dpp(0, __float_as_int(v), 0x12F, 0xf, 0xf, false)); }
struct EpiConvGelu {
    static constexpr int MAP = 1;
    bf16_t* ACT; const float* ss; gfp cw; gfp cb; float* EG; float* EU; LAS float* X;
    __device__ __forceinline__ void operator()(f32x4 (&acc)[2][2][4][2], const Unit& u, int wr, int wc, int fr, int fq) const {
        const int lane = fr + 16 * fq;
        const int row0 = u.pm * BM + wr * 64 + fr, cl = wc * 32 + 8 * fq, f0 = u.pn * 128 + cl;
        LAS float* RS = X + 1024; LAS float* CW = X + 1280;
        { const int tid = (wr * 4 + wc) * 64 + lane;
          if (tid < 256) RS[tid] = __builtin_amdgcn_rsqf(ss[u.pm * BM + tid] * (1.0f / DM) + RMS_EPS);
          else if (tid < 384) { const int i = tid - 256, arr = i >> 5, f4 = i & 31;
              *(LAS f32x4*)(CW + arr * 128 + f4 * 4) = *(const GAS f32x4*)((arr < 3 ? cw + arr * DFF : cb) + u.pn * 128 + f4 * 4); } }
        asm volatile("s_waitcnt vmcnt(0) lgkmcnt(0)" ::: "memory"); __builtin_amdgcn_s_barrier(); asm volatile("" ::: "memory");
        f32x4 w0[2], w1[2], w2[2], bb[2];
#pragma unroll
        for (int n = 0; n < 2; ++n) { w0[n] = *(const LAS f32x4*)(CW + cl + 4 * n); w1[n] = *(const LAS f32x4*)(CW + 128 + cl + 4 * n); w2[n] = *(const LAS f32x4*)(CW + 256 + cl + 4 * n); bb[n] = *(const LAS f32x4*)(CW + 384 + cl + 4 * n); }
#pragma unroll
        for (int ai = 0; ai < 2; ++ai)
#pragma unroll
            for (int m = 0; m < 4; ++m) { const float rs = RS[wr * 64 + fr + ai * HALF + m * 16];
#pragma unroll
                for (int bj = 0; bj < 2; ++bj)
#pragma unroll
                    for (int n = 0; n < 2; ++n) acc[ai][bj][m][n] *= rs; }
        LAS float* XF = X; LAS float* XL = X + 4 * 128;
#pragma unroll
        for (int ai = 0; ai < 2; ++ai) { const int rb = 2 * ai + wr;
            if (fr == 0) { *(LAS f32x4*)(XF + rb * 128 + cl) = acc[ai][0][0][0]; *(LAS f32x4*)(XF + rb * 128 + cl + 4) = acc[ai][0][0][1]; }
            if (fr == 15) { *(LAS f32x4*)(XL + rb * 128 + cl) = acc[ai][0][3][0]; *(LAS f32x4*)(XL + rb * 128 + cl + 4) = acc[ai][0][3][1]; } }
        asm volatile("s_waitcnt lgkmcnt(0)" ::: "memory"); __builtin_amdgcn_s_barrier(); asm volatile("" ::: "memory");
#pragma unroll
        for (int ai = 0; ai < 2; ++ai) {
            const int rb = 2 * ai + wr;
            f32x4 Sprev[2], Scur[2], Tcur[2], Tnext[2];
#pragma unroll
            for (int n = 0; n < 2; ++n) { Sprev[n] = (rb > 0) ? *(const LAS f32x4*)(XL + (rb - 1) * 128 + cl + 4 * n) : (f32x4){0.f, 0.f, 0.f, 0.f};
#pragma unroll
                for (int j = 0; j < 4; ++j) Tcur[n][j] = dpp_rol1(acc[ai][0][0][n][j]); }
#pragma unroll
            for (int m = 0; m < 4; ++m) {
#pragma unroll
                for (int n = 0; n < 2; ++n) {
#pragma unroll
                    for (int j = 0; j < 4; ++j) Scur[n][j] = dpp_ror1(acc[ai][0][m][n][j]);
                    if (m < 3) {
#pragma unroll
                        for (int j = 0; j < 4; ++j) Tnext[n][j] = dpp_rol1(acc[ai][0][m < 3 ? m + 1 : 3][n][j]);
                    } else Tnext[n] = (rb < 3) ? *(const LAS f32x4*)(XF + (rb + 1) * 128 + cl + 4 * n) : (f32x4){0.f, 0.f, 0.f, 0.f};
                }
                const int row = row0 + ai * HALF + m * 16, lrow = row & 255;
                const bool edge = (lrow == 0) || (lrow == 255);
                u32x4 ow;
#pragma unroll
                for (int n = 0; n < 2; ++n) {
                    const f32x4 up = (fr == 0) ? Sprev[n] : Scur[n], dn = (fr == 15) ? Tnext[n] : Tcur[n];
                    const f32x4 a = w0[n] * up + w1[n] * acc[ai][0][m][n] + w2[n] * dn + bb[n];
                    const f32x4 uu = acc[ai][1][m][n];
                    ow[2 * n] = cvt_pk_bf16(gelu_tanh(a[0]) * uu[0], gelu_tanh(a[1]) * uu[1]);
                    ow[2 * n + 1] = cvt_pk_bf16(gelu_tanh(a[2]) * uu[2], gelu_tanh(a[3]) * uu[3]);
                }
                if (!edge) *(u32x4*)(ACT + (size_t)row * DFF + f0) = ow;
                if (lrow < 2 || lrow > 253) { const int e = lrow < 2 ? lrow : lrow - 252; float* eg = EG + ((size_t)u.pm * 4 + e) * DFF + f0;
                    *(f32x4*)eg = acc[ai][0][m][0]; *(f32x4*)(eg + 4) = acc[ai][0][m][1];
                    if (edge) { float* eu = EU + ((size_t)u.pm * 2 + (lrow == 255 ? 1 : 0)) * DFF + f0; *(f32x4*)eu = acc[ai][1][m][0]; *(f32x4*)(eu + 4) = acc[ai][1][m][1]; } }
#pragma unroll
                for (int n = 0; n < 2; ++n) { Sprev[n] = Scur[n]; Tcur[n] = Tnext[n]; }
            }
        }
    }
};

template <class Epi, class Sched, bool ALIGN_EPI = true, bool SP2 = true>
__device__ __forceinline__ void gemm_phase(LAS unsigned char* lds, const Gemm g, const Sched& S, const Epi& E, const int tid) {
    const int wid = __builtin_amdgcn_readfirstlane(tid >> 6), lane = tid & 63, wr = wid >> 2, wc = wid & 3, fr = lane & 15, fq = lane >> 4;
    const int K = g.K, nt = K / BK, lda = g.lda;
    unsigned voffA[2], voffB0[2], voffB1[2];
#pragma unroll
    for (int i = 0; i < 2; ++i) { int R, C; stage_rc(tid * 16 + i * 8192, R, C);
        voffA[i] = (unsigned)(R * lda + C) * 2u;
        if constexpr (Epi::MAP == 2) { const int wcR = R >> 5, rho = R & 31, nn = rho >> 4, ii = rho & 15, tr = 64 * wcR + 16 * (ii >> 2) + 4 * nn + (ii & 3);
            voffB0[i] = (unsigned)(tr * K + C) * 2u; voffB1[i] = (unsigned)((tr + 8) * K + C) * 2u; }
        else { const int Rb = (R & ~31) + perm32(R & 31); voffB0[i] = voffB1[i] = (unsigned)(Rb * K + C) * 2u; } }
    const size_t kstep = (size_t)(BK * 2);
    const size_t hstepA = (size_t)HALF * lda * 2, tstepA = 2 * hstepA, tstepB = (size_t)BM * K * 2;
    const size_t hstepB = (Epi::MAP == 2) ? (size_t)0 : (size_t)HALF * K * 2;
    const unsigned ldsw = (unsigned)wid * 1024u;
    const int aoff = lds_byte(wr * 64 + fr, fq * 8), boff = lds_byte(wc * 32 + fr, fq * 8);
#define PG8_SA(b, h) (((b) * 2 + (h)) * HTB)
#define PG8_SB(b, h) ((4 + (b) * 2 + (h)) * HTB)
#define PG8_STAGE(bufoff, gbase, voff) do { _Pragma("unroll") for (int _i = 0; _i < 2; ++_i) \
        __builtin_amdgcn_global_load_lds((const unsigned*)((const char*)(gbase) + (voff)[_i]), (LAS unsigned*)(lds + (bufoff) + ldsw + _i * 8192), 16, 0, 0); } while (0)
#define PG8_LDA(dst, b, h) do { _Pragma("unroll") for (int m = 0; m < 4; ++m) _Pragma("unroll") for (int k = 0; k < 2; ++k) dst[m][k] = *(const LAS bf16x8*)(lds + PG8_SA(b, h) + aoff + m * 2048 + k * 1024); } while (0)
#define PG8_LDB(dst, b, h) do { _Pragma("unroll") for (int n = 0; n < 2; ++n) _Pragma("unroll") for (int k = 0; k < 2; ++k) dst[n][k] = *(const LAS bf16x8*)(lds + PG8_SB(b, h) + boff + n * 2048 + k * 1024); } while (0)
#define PG8_MMA(ai, bj, At, Bt) do { __builtin_amdgcn_s_setprio(1); _Pragma("unroll") for (int m = 0; m < 4; ++m) _Pragma("unroll") for (int n = 0; n < 2; ++n) _Pragma("unroll") for (int k = 0; k < 2; ++k) \
        acc[ai][bj][m][n] = __builtin_amdgcn_mfma_f32_16x16x32_bf16(Bt[n][k], At[m][k], acc[ai][bj][m][n], 0, 0, 0); __builtin_amdgcn_s_setprio(0); } while (0)
#define PG8_WAIT_V(n) asm volatile("s_waitcnt vmcnt(" #n ")" ::: "memory")
#define PG8_WAIT_L(n) asm volatile("s_waitcnt lgkmcnt(" #n ")" ::: "memory")
#define PG8_BAR __builtin_amdgcn_s_barrier()
#define PG8_SCHED __builtin_amdgcn_sched_barrier(0)
    Unit cur, nxt; int ui = 0;
    if (!S.next(0, cur)) return;
    f32x4 acc[2][2][4][2];
#pragma unroll
    for (int a = 0; a < 2; ++a)
#pragma unroll
        for (int b = 0; b < 2; ++b)
#pragma unroll
            for (int m = 0; m < 4; ++m)
#pragma unroll
                for (int n = 0; n < 2; ++n) acc[a][b][m][n] = (f32x4){0.f, 0.f, 0.f, 0.f};
    bf16x8 At[4][2], B0[2][2], B1[2][2];
    const char* cA = (const char*)g.A + (size_t)cur.pm * tstepA; const char* cB = (const char*)g.Bt + (size_t)cur.pn * tstepB;
    static_assert(SP2, "only the SP2 loop is kept");
    PG8_STAGE(PG8_SB(0, 0), cB, voffB0); PG8_STAGE(PG8_SB(0, 1), cB + hstepB, voffB1); PG8_STAGE(PG8_SA(0, 0), cA, voffA); PG8_STAGE(PG8_SA(0, 1), cA + hstepA, voffA);
    if (wr == 1) PG8_BAR;
    PG8_WAIT_V(2); PG8_BAR;
    PG8_STAGE(PG8_SB(1, 0), cB + kstep, voffB0); PG8_STAGE(PG8_SA(1, 0), cA + kstep, voffA); PG8_STAGE(PG8_SB(1, 1), cB + hstepB + kstep, voffB1);
    PG8_WAIT_V(6); PG8_BAR;
    for (;;) {
        const bool has_next = S.next(ui + 1, nxt);
        const char* nA = has_next ? (const char*)g.A + (size_t)nxt.pm * tstepA : cA; const char* nB = has_next ? (const char*)g.Bt + (size_t)nxt.pn * tstepB : cB;
        for (int t = 0; t < nt; t += 2) {
            const bool last = (t == nt - 2);
            const char* a1 = cA + (size_t)(t + 1) * kstep;
            const char* a2 = last ? nA : cA + (size_t)(t + 2) * kstep; const char* b2 = last ? nB : cB + (size_t)(t + 2) * kstep;
            const char* a3 = a2 + kstep; const char* b3 = b2 + kstep;
            PG8_LDB(B0, 0, 0); PG8_LDB(B1, 0, 1); PG8_SCHED; PG8_LDA(At, 0, 0); PG8_STAGE(PG8_SA(1, 1), a1 + hstepA, voffA);
            PG8_WAIT_V(8); PG8_WAIT_L(0); PG8_BAR; PG8_MMA(0, 0, At, B0); PG8_MMA(0, 1, At, B1); PG8_BAR; PG8_SCHED;
            PG8_LDA(At, 0, 1); PG8_STAGE(PG8_SB(0, 0), b2, voffB0); PG8_STAGE(PG8_SB(0, 1), b2 + hstepB, voffB1); PG8_STAGE(PG8_SA(0, 0), a2, voffA);
            PG8_WAIT_V(8); PG8_WAIT_L(0); PG8_BAR; PG8_MMA(1, 0, At, B0); PG8_MMA(1, 1, At, B1); PG8_BAR; PG8_SCHED;
            PG8_LDB(B0, 1, 0); PG8_LDB(B1, 1, 1); PG8_SCHED; PG8_LDA(At, 1, 0); PG8_STAGE(PG8_SA(0, 1), a2 + hstepA, voffA);
            PG8_WAIT_V(8); PG8_WAIT_L(0); PG8_BAR; PG8_MMA(0, 0, At, B0); PG8_MMA(0, 1, At, B1); PG8_BAR; PG8_SCHED;
            PG8_LDA(At, 1, 1); PG8_STAGE(PG8_SB(1, 0), b3, voffB0); PG8_STAGE(PG8_SB(1, 1), b3 + hstepB, voffB1); PG8_STAGE(PG8_SA(1, 0), a3, voffA);
            PG8_WAIT_V(8); PG8_WAIT_L(0); PG8_BAR; PG8_MMA(1, 0, At, B0); PG8_MMA(1, 1, At, B1); PG8_BAR; PG8_SCHED;
        }
        if constexpr (ALIGN_EPI) { if (wr == 0) PG8_BAR; }
        E(acc, cur, wr, wc, fr, fq);
        if (!has_next) break;
#pragma unroll
        for (int a = 0; a < 2; ++a)
#pragma unroll
            for (int b = 0; b < 2; ++b)
#pragma unroll
                for (int m = 0; m < 4; ++m)
#pragma unroll
                    for (int n = 0; n < 2; ++n) acc[a][b][m][n] = (f32x4){0.f, 0.f, 0.f, 0.f};
        cur = nxt; cA = nA; cB = nB; ++ui;
        if constexpr (ALIGN_EPI) { if (wr == 1) PG8_BAR; }
    }
    PG8_WAIT_V(0);
    if constexpr (!ALIGN_EPI) { if (wr == 0) PG8_BAR; }
    PG8_BAR;
#undef PG8_SA
#undef PG8_SB
#undef PG8_STAGE
#undef PG8_LDA
#undef PG8_LDB
#undef PG8_MMA
#undef PG8_WAIT_V
#undef PG8_WAIT_L
#undef PG8_BAR
#undef PG8_SCHED
}
}

namespace att {
constexpr int D = 128, QBLK = 32, KVBLK = 64;
constexpr float SCALE = ATT_SCALE;
constexpr float THR = 8.f;
constexpr int SHM_V = KVBLK * D * 2, SHM_K = KVBLK * D * 2;
constexpr int LUT_OFF = 69632;
constexpr int QL_OFF = 102400;
#define KSWZ(row, colB) ((row) * 256 + ((colB) ^ (((row) & 7) << 4)))
#define SBAR() __builtin_amdgcn_sched_barrier(0)
__device__ __forceinline__ int crow(int r, int hi) { return (r & 3) + 8 * (r >> 2) + 4 * hi; }

struct AttnP {
    const bf16_t* Q; const bf16_t* K; const bf16_t* V; bf16_t* O; float* lse;
    long ldq, ldk, ldo; int lse_ld;
    int NT;
    const float* lut; int lut_n;
    int lbase;
    int krow0, qtok0;
    int far_thr, q0abs, cidx;
};

__device__ __forceinline__ void partialSM(f32x16& p0, f32x16& p1, float& m_reg, float& mn, float& alpha, const float cb = 0.f) {
    constexpr float C = SCALE * 1.4426950408889634f;
    float pmax = p0[0];
#pragma unroll
    for (int r = 1; r < 16; ++r) pmax = fmaxf(pmax, p0[r]);
#pragma unroll
    for (int r = 0; r < 16; ++r) pmax = fmaxf(pmax, p1[r]);
    { auto rr = __builtin_amdgcn_permlane32_swap(__float_as_uint(pmax), __float_as_uint(pmax), false, false);
      pmax = fmaxf(__uint_as_float(rr[0]), __uint_as_float(rr[1])) + cb; }
    if (__builtin_expect(__all(pmax - m_reg <= THR / SCALE), 1)) { mn = m_reg; alpha = 1.f; }
    else { mn = fmaxf(m_reg, pmax); alpha = __builtin_amdgcn_exp2f((m_reg - mn) * C); m_reg = mn; }
    float mnC = (cb - mn) * C;
#pragma unroll
    for (int r = 0; r < 16; ++r) p0[r] = fmaf(p0[r], C, mnC);
#pragma unroll
    for (int r = 0; r < 16; ++r) p1[r] = fmaf(p1[r], C, mnC);
#pragma unroll
    for (int r = 0; r < 16; ++r) p0[r] = __builtin_amdgcn_exp2f(p0[r]);
}
__device__ __forceinline__ void finishSM(f32x16& p0, f32x16& p1, float alpha, float& l_reg, bf16x8& pa0, bf16x8& pa1, bf16x8& pa2, bf16x8& pa3) {
#pragma unroll
    for (int r = 0; r < 16; ++r) p1[r] = __builtin_amdgcn_exp2f(p1[r]);
    float ps = 0;
#pragma unroll
    for (int r = 0; r < 16; ++r) ps += p0[r];
#pragma unroll
    for (int r = 0; r < 16; ++r) ps += p1[r];
    { auto rr = __builtin_amdgcn_permlane32_swap(__float_as_uint(ps), __float_as_uint(ps), false, false);
      ps = __uint_as_float(rr[0]) + __uint_as_float(rr[1]); }
    l_reg = l_reg * alpha + ps;
#define PK4(P, BASE, OUT) do { unsigned a0 = cvt_pk_bf16(P[BASE + 0], P[BASE + 1]), a1 = cvt_pk_bf16(P[BASE + 2], P[BASE + 3]);   \
    unsigned b0 = cvt_pk_bf16(P[BASE + 4], P[BASE + 5]), b1 = cvt_pk_bf16(P[BASE + 6], P[BASE + 7]);                              \
    auto r0 = __builtin_amdgcn_permlane32_swap(a0, b0, false, false); auto r1 = __builtin_amdgcn_permlane32_swap(a1, b1, false, false); \
    u32x4 w = {r0[0], r1[0], r0[1], r1[1]}; OUT = *reinterpret_cast<bf16x8*>(&w); } while (0)
    PK4(p0, 0, pa0); PK4(p0, 8, pa1); PK4(p1, 0, pa2); PK4(p1, 8, pa3);
#undef PK4
}
template <bool QL>
__device__ __forceinline__ void qkt(f32x16& p0, f32x16& p1, const char* Ks, const bf16x8* qr, const LAS char* qlds, int r32, int hi) {
    p0 = f32x16{}; p1 = f32x16{};
#pragma unroll
    for (int d0 = 0; d0 < 8; ++d0) { int cb = (d0 * 16 + hi * 8) * 2;
        bf16x8 b0 = *reinterpret_cast<const bf16x8*>(Ks + KSWZ(r32, cb));
        bf16x8 b1 = *reinterpret_cast<const bf16x8*>(Ks + KSWZ(32 + r32, cb));
        bf16x8 q;
        if constexpr (QL) { if (d0 < 4) q = qr[d0]; else q = *(const volatile LAS bf16x8*)(qlds + (d0 - 4) * 1024); } else q = qr[d0];
        p0 = __builtin_amdgcn_mfma_f32_32x32x16_bf16(b0, q, p0, 0, 0, 0);
        p1 = __builtin_amdgcn_mfma_f32_32x32x16_bf16(b1, q, p1, 0, 0, 0); }
}
__device__ __forceinline__ int v_st(int k, int c) { const int kk = (k & ~0xC) | ((k & 4) << 1) | ((k & 8) >> 1); return ((kk >> 3) * 4 + (c >> 5)) * 512 + ((kk & 7) * 32 + (c & 31)) * 2; }
__device__ __forceinline__ int v_rd_base(int lane) { return ((lane & 3) << 3) | (((lane >> 2) & 3) << 6) | (((lane >> 4) & 1) << 5) | (((lane >> 5) & 1) << 8); }
constexpr int v_rd_off(int d0, int ks, int half) { return d0 * 512 + ks * 4096 + half * 2048; }
template <int OFF> __device__ __forceinline__ s16x4 tr_read(int vb) {
    s16x4 r; asm volatile("ds_read_b64_tr_b16 %0, %1 offset:%2" : "=&v"(r) : "v"(vb), "i"(OFF) : "memory"); return r;
}
template <int D0> __device__ __forceinline__ void pv_one(f32x16& od, int vb, bf16x8 pa0, bf16x8 pa1, bf16x8 pa2, bf16x8 pa3) {
    const s16x4 l0 = tr_read<v_rd_off(D0, 0, 0)>(vb), h0 = tr_read<v_rd_off(D0, 0, 1)>(vb), l1 = tr_read<v_rd_off(D0, 1, 0)>(vb), h1 = tr_read<v_rd_off(D0, 1, 1)>(vb);
    const s16x4 l2 = tr_read<v_rd_off(D0, 2, 0)>(vb), h2 = tr_read<v_rd_off(D0, 2, 1)>(vb), l3 = tr_read<v_rd_off(D0, 3, 0)>(vb), h3 = tr_read<v_rd_off(D0, 3, 1)>(vb);
    asm volatile("s_waitcnt lgkmcnt(0)" ::: "memory"); SBAR();
#define PK(L, H) (bf16x8){L[0], L[1], L[2], L[3], H[0], H[1], H[2], H[3]}
    od = __builtin_amdgcn_mfma_f32_32x32x16_bf16(pa0, PK(l0, h0), od, 0, 0, 0);
    od = __builtin_amdgcn_mfma_f32_32x32x16_bf16(pa1, PK(l1, h1), od, 0, 0, 0);
    od = __builtin_amdgcn_mfma_f32_32x32x16_bf16(pa2, PK(l2, h2), od, 0, 0, 0);
    od = __builtin_amdgcn_mfma_f32_32x32x16_bf16(pa3, PK(l3, h3), od, 0, 0, 0);
#undef PK
}
__device__ __forceinline__ void pv_d0(f32x16* o, int vb, bf16x8 pa0, bf16x8 pa1, bf16x8 pa2, bf16x8 pa3) {
    pv_one<0>(o[0], vb, pa0, pa1, pa2, pa3); pv_one<1>(o[1], vb, pa0, pa1, pa2, pa3); pv_one<2>(o[2], vb, pa0, pa1, pa2, pa3); pv_one<3>(o[3], vb, pa0, pa1, pa2, pa3);
}

struct ModeCtx { int lidx; int rs, cs, qi, qj; int krow0; int far_thr, qlo; float cpos, cneg; };
template <int MODE> __device__ __forceinline__ float apply_mode(f32x16& p0, f32x16& p1, int t, const ModeCtx& c, const LAS float* lut, int hi) {
    float cb = 0.f;
    if constexpr (MODE == 1 || MODE == 2) {
        const int klo = t * 64;
        if (klo - (c.qlo + 31) >= c.far_thr) cb = c.cpos;
        else if (c.qlo - (klo + 63) >= c.far_thr) cb = c.cneg;
        else {
        const LAS float* L = lut + (c.lidx + t * 64);
#pragma unroll
        for (int g = 0; g < 4; ++g) {
            float b0[4], b1[4];
#pragma unroll
            for (int q = 0; q < 4; ++q) { b0[q] = L[8 * g + q]; b1[q] = L[32 + 8 * g + q]; }
#pragma unroll
            for (int q = 0; q < 4; ++q) { p0[4 * g + q] += b0[q]; p1[4 * g + q] += b1[q]; }
        }
        }
    } else if constexpr (MODE == 3) {
        const int ki = c.krow0 + t;
        const bool rowok = (unsigned)(ki - c.rs) < 8u;
        const int base = (ki - c.qi + 7) * 31 + 15 - c.qj + 4 * hi;
        const int kjb = 4 * hi - c.cs;
#pragma unroll
        for (int r = 0; r < 16; ++r) {
            const int kj0 = (r & 3) + 8 * (r >> 2);
            const bool ok0 = rowok && ((unsigned)(kjb + kj0) < 16u), ok1 = rowok && ((unsigned)(kjb + kj0 + 32) < 16u);
            const float v0 = lut[ok0 ? base + kj0 : 0], v1 = lut[ok1 ? base + kj0 + 32 : 0];
            p0[r] = ok0 ? p0[r] + v0 : -INFINITY; p1[r] = ok1 ? p1[r] + v1 : -INFINITY;
        }
    }
    return cb;
}

template <int MODE, int SDEPTH, bool QL>
__device__ __forceinline__ void attn_unit(const AttnP& P, char* lds, const int tid) {
    const int wid = tid >> 6, lane = tid & 63, r32 = lane & 31, hi = lane >> 5;
    char* V_lds = lds; char* K_lds = lds + 2 * SHM_V;
    float* ws = (float*)(lds + 2 * SHM_V + 2 * SHM_K) + wid * 64; float* li_l = ws; float* al_l = ws + 32;
    const LAS float* lut = (const LAS float*)((LAS char*)lds + LUT_OFF);
    __syncthreads();
    if constexpr (MODE != 0) { for (int i = tid; i < P.lut_n; i += NTHREADS) ((LAS float*)lut)[i] = P.lut[i]; }
    ModeCtx mc; mc.lidx = 0; mc.rs = mc.cs = mc.qi = mc.qj = 0; mc.krow0 = P.krow0; mc.far_thr = P.far_thr; mc.qlo = P.q0abs + wid * QBLK; mc.cpos = 0.f; mc.cneg = 0.f;
    if constexpr (MODE == 1 || MODE == 2) mc.lidx = P.lbase - (wid * QBLK + r32) + 4 * hi;
    if constexpr (MODE == 3) { const int tq = P.qtok0 + wid * QBLK + r32; mc.qi = tq >> 6; mc.qj = tq & 63;
        mc.rs = min(max(mc.qi - 4, 0), 56); mc.cs = min(max(mc.qj - 8, 0), 48); }
    float m_reg = -1e30f, l_reg = 0; f32x16 o[4] = {}; bf16x8 qr[QL ? 4 : 8];
    const LAS char* qlds = (const LAS char*)lds + QL_OFF + wid * 4096 + lane * 16;
    const bf16_t* Qw = P.Q + (long)(wid * QBLK + r32) * P.ldq + hi * 8;
#pragma unroll
    for (int d0 = 0; d0 < 8; ++d0) { const bf16x8 qv = *reinterpret_cast<const bf16x8*>(Qw + d0 * 16);
        if (QL && d0 >= 4) *(LAS bf16x8*)((LAS char*)qlds + (d0 - 4) * 1024) = qv; else qr[d0 < (QL ? 4 : 8) ? d0 : 0] = qv; }
    const int sr = tid >> 4, sc = (tid & 15) * 8, vst0 = v_st(sr, sc), vst1 = v_st(32 + sr, sc);
    const int vb0 = (int)(uintptr_t)V_lds + v_rd_base(lane);
    const bf16_t* Kh = P.K; const bf16_t* Vh = P.V; const long LDK = P.ldk;
    struct { bf16x8 vs0, vs1, ks0, ks1; } sr_[SDEPTH];
    const unsigned goff0 = (unsigned)((sr * LDK + sc) * 2), goff1 = (unsigned)(((32 + sr) * LDK + sc) * 2);
#define SLOAD(i, k0) do { const char* kb_ = (const char*)Kh + (size_t)(k0) * (size_t)LDK * 2; const char* vb_ = (const char*)Vh + (size_t)(k0) * (size_t)LDK * 2; \
    sr_[i].vs0 = *(const bf16x8*)(vb_ + goff0); sr_[i].vs1 = *(const bf16x8*)(vb_ + goff1); \
    sr_[i].ks0 = *(const bf16x8*)(kb_ + goff0); sr_[i].ks1 = *(const bf16x8*)(kb_ + goff1); } while (0)
#define SWRITE(b, i) do { *(bf16x8*)(V_lds + (b) * SHM_V + vst0) = sr_[i].vs0;          \
    *(bf16x8*)(V_lds + (b) * SHM_V + vst1) = sr_[i].vs1; int kc = sc * 2;               \
    *(bf16x8*)(K_lds + (b) * SHM_K + KSWZ(sr, kc)) = sr_[i].ks0;                       \
    *(bf16x8*)(K_lds + (b) * SHM_K + KSWZ(32 + sr, kc)) = sr_[i].ks1; } while (0)
#define SWAIT() do { if constexpr (SDEPTH == 2) asm volatile("s_waitcnt vmcnt(4)" ::: "memory"); else asm volatile("s_waitcnt vmcnt(0)" ::: "memory"); } while (0)
#define RESC(a) do { if (__any((a) < 1.f)) { if (hi == 0) al_l[r32] = (a); asm volatile("s_waitcnt lgkmcnt(0)" ::: "memory"); \
    _Pragma("unroll") for (int d = 0; d < 4; ++d) _Pragma("unroll") for (int r = 0; r < 16; ++r) o[d][r] *= al_l[crow(r, hi)]; } } while (0)
    f32x16 pA0, pA1, pB0, pB1; float mnA, mnB, alA, alB; bf16x8 pa0, pa1, pa2, pa3; const int NT = P.NT;
    constexpr int SE = 0, SO = SDEPTH - 1;
    SLOAD(SE, 0); asm volatile("s_waitcnt vmcnt(0)" ::: "memory"); SWRITE(0, SE); __syncthreads();
    if constexpr (MODE == 1) { if (P.far_thr < (1 << 20)) { mc.cpos = lut[P.cidx + P.far_thr]; mc.cneg = lut[P.cidx - P.far_thr]; } }
    qkt<QL>(pA0, pA1, K_lds, qr, qlds, r32, hi); { const float cb_ = apply_mode<MODE>(pA0, pA1, 0, mc, lut, hi); partialSM(pA0, pA1, m_reg, mnA, alA, cb_); }
    SLOAD(SO, KVBLK); if constexpr (SDEPTH == 2) { if (2 < NT) SLOAD(SE, 2 * KVBLK); }
    SWAIT(); SWRITE(1, SO); __syncthreads();
    for (int j = 1; j + 1 < NT; j += 2) {
        SBAR(); qkt<QL>(pB0, pB1, K_lds + SHM_K, qr, qlds, r32, hi);
        finishSM(pA0, pA1, alA, l_reg, pa0, pa1, pa2, pa3); SBAR();
        SLOAD(SO, (j + SDEPTH) * KVBLK); SBAR();
        pv_d0(o, vb0, pa0, pa1, pa2, pa3); { const float cb_ = apply_mode<MODE>(pB0, pB1, j, mc, lut, hi); partialSM(pB0, pB1, m_reg, mnB, alB, cb_); }
        __syncthreads(); SWAIT(); SWRITE(0, SE);
        RESC(alB); __syncthreads();
        SBAR(); qkt<QL>(pA0, pA1, K_lds, qr, qlds, r32, hi);
        finishSM(pB0, pB1, alB, l_reg, pa0, pa1, pa2, pa3); SBAR();
        if (SDEPTH == 1 || j + 3 < NT) SLOAD(SE, (j + 1 + SDEPTH) * KVBLK); SBAR();
        pv_d0(o, vb0 + SHM_V, pa0, pa1, pa2, pa3); { const float cb_ = apply_mode<MODE>(pA0, pA1, j + 1, mc, lut, hi); partialSM(pA0, pA1, m_reg, mnA, alA, cb_); }
        __syncthreads(); SWAIT(); SWRITE(1, SO);
        RESC(alA); __syncthreads();
    }
    SBAR(); qkt<QL>(pB0, pB1, K_lds + SHM_K, qr, qlds, r32, hi);
    finishSM(pA0, pA1, alA, l_reg, pa0, pa1, pa2, pa3); SBAR();
    pv_d0(o, vb0, pa0, pa1, pa2, pa3); { const float cb_ = apply_mode<MODE>(pB0, pB1, NT - 1, mc, lut, hi); partialSM(pB0, pB1, m_reg, mnB, alB, cb_); }
    __syncthreads(); RESC(alB);
    finishSM(pB0, pB1, alB, l_reg, pa0, pa1, pa2, pa3); SBAR();
    pv_d0(o, vb0 + SHM_V, pa0, pa1, pa2, pa3);
    if (hi == 0) li_l[r32] = l_reg; asm volatile("s_waitcnt lgkmcnt(0)" ::: "memory");
    if (P.lse != nullptr && hi == 0) P.lse[(long)(wid * QBLK + r32) * P.lse_ld] = m_reg * SCALE + __logf(l_reg);
    float rli[16];
#pragma unroll
    for (int r = 0; r < 16; ++r) rli[r] = __builtin_amdgcn_rcpf(li_l[crow(r, hi)]);
    __syncthreads();
    {
        char* st = lds + wid * 10240;
        const bool odd = (r32 & 1) != 0;
        const int sbase = (crow(0, hi) + (odd ? 1 : 0)) * 320 + (r32 & ~1) * 2;
#pragma unroll
        for (int d0 = 0; d0 < 4; ++d0)
#pragma unroll
            for (int rp = 0; rp < 8; ++rp) { const int r = 2 * rp;
                const float a = o[d0][r] * rli[r], b = o[d0][r + 1] * rli[r + 1];
                const float t = odd ? a : b; const float rcv = dpp_xor1(t);
                const unsigned w = odd ? cvt_pk_bf16(rcv, b) : cvt_pk_bf16(a, rcv);
                *(unsigned*)(st + sbase + (crow(r, 0)) * 320 + d0 * 64) = w; }
        asm volatile("s_waitcnt lgkmcnt(0)" ::: "memory");
        bf16_t* Ow = P.O + (long)(wid * QBLK) * P.ldo;
#pragma unroll
        for (int i = 0; i < 8; ++i) { const int chunk = i * 64 + lane, row = chunk >> 4, c16 = chunk & 15;
            const u32x4 v = *(const u32x4*)(st + row * 320 + c16 * 16);
            *(u32x4*)(Ow + (long)row * P.ldo + c16 * 8) = v; }
    }
#undef SLOAD
#undef SWRITE
#undef SWAIT
#undef RESC
}

constexpr int B_V = 0, B_K = 65536, B_WS = 98304, B_QL = 100352, B_LUT = 133120;
template <int MODE, int VW>
__device__ __forceinline__ void attn_unit_s(const AttnP& P, char* lds, const int tid) {
    const int wid = __builtin_amdgcn_readfirstlane(tid >> 6), lane = tid & 63, r32 = lane & 31, hi = lane >> 5;
    char* V_lds = lds + B_V; char* K_lds = lds + B_K;
    float* ws = (float*)(lds + B_WS) + wid * 64; float* li_l = ws; float* al_l = ws + 32;
    const LAS float* lut = (const LAS float*)((LAS char*)lds + B_LUT);
    __syncthreads();
    if constexpr (MODE != 0) { for (int i = tid; i < P.lut_n; i += NTHREADS) ((LAS float*)lut)[i] = P.lut[i]; }
    ModeCtx mc; mc.rs = mc.cs = mc.qi = mc.qj = 0; mc.krow0 = P.krow0; mc.far_thr = P.far_thr; mc.qlo = P.q0abs + wid * QBLK; mc.cpos = 0.f; mc.cneg = 0.f;
    mc.lidx = P.lbase - (wid * QBLK + r32) + 4 * hi;
    if constexpr (MODE == 3) { const int tq = P.qtok0 + wid * QBLK + r32; mc.qi = tq >> 6; mc.qj = tq & 63; mc.rs = min(max(mc.qi - 4, 0), 56); mc.cs = min(max(mc.qj - 8, 0), 48); }
    int t_lo = 0, t_hi = P.NT;
    if constexpr (MODE == 1) { if (P.far_thr >= (1 << 20)) { const int qlo = 512 - P.lbase + wid * QBLK; t_lo = max(0, (qlo - 64) >> 6); t_hi = min(P.NT, ((qlo + 31 + 64) >> 6) + 1); } }
    if constexpr (MODE == 3) { const int qi0 = (P.qtok0 + wid * QBLK) >> 6, rs0 = min(max(qi0 - 4, 0), 56); t_lo = rs0 - P.krow0; t_hi = t_lo + 8; }
    float m_reg = -1e30f, l_reg = 0; f32x16 o[4 * VW] = {}; bf16x8 qr[4];
    const LAS char* qlds = (const LAS char*)lds + B_QL + wid * 4096 + lane * 16;
    const bf16_t* Qw = P.Q + (long)(wid * QBLK + r32) * P.ldq + hi * 8;
#pragma unroll
    for (int d0 = 0; d0 < 8; ++d0) { const bf16x8 qv = *reinterpret_cast<const bf16x8*>(Qw + d0 * 16);
        if (d0 >= 4) *(LAS bf16x8*)((LAS char*)qlds + (d0 - 4) * 1024) = qv; else qr[d0 < 4 ? d0 : 0] = qv; }
    const int vb0 = (int)(uintptr_t)V_lds + v_rd_base(lane);
    const long LDK = P.ldk;
    unsigned offK[2], offV[2];
#pragma unroll
    for (int i = 0; i < 2; ++i) { const int sl = tid + 512 * i, row = sl >> 4, ch = (sl & 15) ^ (row & 7); offK[i] = (unsigned)((row * LDK + ch * 8) * 2); }
#pragma unroll
    for (int i = 0; i < 2; ++i) { const int sl = tid + 512 * i, sub = sl >> 5, rowk = (sl >> 2) & 7, cch = sl & 3, kk = (sub >> 2) * 8 + rowk;
        const int k = (kk & ~0xC) | ((kk & 4) << 1) | ((kk & 8) >> 1), col = (sub & 3) * 32 + cch * 8; offV[i] = (unsigned)((k * LDK + col) * 2); }
    LAS unsigned char* ldsw = (LAS unsigned char*)lds + wid * 1024;
#define BDMA(b, k0) do { const char* kb_ = (const char*)P.K + (size_t)(k0) * (size_t)LDK * 2; const char* vp_ = (const char*)P.V + (size_t)(k0) * (size_t)LDK * 2; \
    _Pragma("unroll") for (int _i = 0; _i < 2; ++_i) __builtin_amdgcn_global_load_lds((const unsigned*)(kb_ + offK[_i]), (LAS unsigned*)(ldsw + B_K + (b) * SHM_K + _i * 8192), 16, 0, 0); \
    _Pragma("unroll") for (int _i = 0; _i < 2 * VW; ++_i) __builtin_amdgcn_global_load_lds((const unsigned*)(vp_ + (_i >> 1) * 256 + offV[_i & 1]), (LAS unsigned*)(ldsw + B_V + (b) * 32768 + (_i >> 1) * 16384 + (_i & 1) * 8192), 16, 0, 0); } while (0)
    BDMA(0, 0); asm volatile("s_waitcnt vmcnt(0)" ::: "memory"); __syncthreads();
    if constexpr (MODE == 1) if (P.far_thr < (1 << 20)) { mc.cpos = __uint_as_float(__builtin_amdgcn_readfirstlane(__float_as_uint(lut[P.cidx + P.far_thr]))); mc.cneg = __uint_as_float(__builtin_amdgcn_readfirstlane(__float_as_uint(lut[P.cidx - P.far_thr]))); }
    const int NT = P.NT;
    for (int j = 0; j < NT; ++j) {
        const int b = j & 1;
        if (j + 1 < NT) BDMA(b ^ 1, (j + 1) * KVBLK);
        if (j >= t_lo && j < t_hi) {
        f32x16 p0, p1; float mn, alpha; bf16x8 pa0, pa1, pa2, pa3;
        SBAR(); qkt<true>(p0, p1, K_lds + b * SHM_K, qr, qlds, r32, hi);
        const float cb_ = apply_mode<MODE>(p0, p1, j, mc, lut, hi); partialSM(p0, p1, m_reg, mn, alpha, cb_);
        if (__any(alpha < 1.f)) { if (hi == 0) al_l[r32] = alpha; asm volatile("s_waitcnt lgkmcnt(0)" ::: "memory");
#pragma unroll
            for (int d = 0; d < 4 * VW; ++d)
#pragma unroll
                for (int r = 0; r < 16; ++r) o[d][r] *= al_l[crow(r, hi)]; }
        finishSM(p0, p1, alpha, l_reg, pa0, pa1, pa2, pa3); SBAR();
        pv_d0(o, vb0 + b * 32768, pa0, pa1, pa2, pa3); if constexpr (VW == 2) pv_d0(o + 4, vb0 + b * 32768 + 16384, pa0, pa1, pa2, pa3);
        }
        asm volatile("s_waitcnt vmcnt(0)" ::: "memory");
        __syncthreads();
    }
    if (hi == 0) li_l[r32] = l_reg; asm volatile("s_waitcnt lgkmcnt(0)" ::: "memory");
    if (P.lse != nullptr && hi == 0) P.lse[(long)(wid * QBLK + r32) * P.lse_ld] = m_reg * SCALE + __logf(l_reg);
    float rli[16];
#pragma unroll
    for (int r = 0; r < 16; ++r) rli[r] = __builtin_amdgcn_rcpf(li_l[crow(r, hi)]);
    {
        char* st = lds + wid * 10240;
        const bool odd = (r32 & 1) != 0;
        const int sbase = (crow(0, hi) + (odd ? 1 : 0)) * 320 + (r32 & ~1) * 2;
        bf16_t* Ow = P.O + (long)(wid * QBLK) * P.ldo;
#pragma unroll
        for (int hv = 0; hv < VW; ++hv) {
#pragma unroll
            for (int d0 = 0; d0 < 4; ++d0)
#pragma unroll
                for (int rp = 0; rp < 8; ++rp) { const int r = 2 * rp;
                    const float a = o[hv * 4 + d0][r] * rli[r], bb = o[hv * 4 + d0][r + 1] * rli[r + 1];
                    const float t = odd ? a : bb; const float rcv = dpp_xor1(t);
                    const unsigned w = odd ? cvt_pk_bf16(rcv, bb) : cvt_pk_bf16(a, rcv);
                    *(unsigned*)(st + sbase + (crow(r, 0)) * 320 + d0 * 64) = w; }
            asm volatile("s_waitcnt lgkmcnt(0)" ::: "memory");
#pragma unroll
            for (int i = 0; i < 8; ++i) { const int chunk = i * 64 + lane, row = chunk >> 4, c16 = chunk & 15;
                const u32x4 v = *(const u32x4*)(st + row * 320 + c16 * 16);
                *(u32x4*)(Ow + (long)row * P.ldo + hv * 128 + c16 * 8) = v; }
            asm volatile("s_waitcnt lgkmcnt(0)" ::: "memory");
        }
    }
#undef BDMA
}
}

#define XB_TMO      128
#define XB_XCNT(j)  (256  + 64 * (j))
#define XB_XSUB(j)  (1280 + 64 * (j))
#define XB_XGEN(j)  (2304 + 64 * (j))
#define XB_TOP      3328
#define XB_TOPGEN   3392
#define XCD_BAR_WORDS 3456
#define XB_SPIN_CAP (1u << 22)
__device__ __forceinline__ unsigned xb_ld(unsigned* p)              { return __hip_atomic_load(p, __ATOMIC_RELAXED, __HIP_MEMORY_SCOPE_AGENT); }
__device__ __forceinline__ unsigned xb_add(unsigned* p, unsigned v) { return __hip_atomic_fetch_add(p, v, __ATOMIC_RELAXED, __HIP_MEMORY_SCOPE_AGENT); }
__device__ __forceinline__ unsigned xb_xcc_id() { return (unsigned)__builtin_amdgcn_s_getreg((3 << 11) | 20) & 0xFu; }
#define XB_SPIN(cond, bar) do { unsigned _sp = 0; while (cond) { __builtin_amdgcn_s_sleep(1); \
    if ((++_sp & 255u) == 0u) { if (xb_ld(&(bar)[XB_TMO])) break; if (_sp > XB_SPIN_CAP) { atomicAdd(&(bar)[XB_TMO], 1u); break; } } } } while (0)
__device__ __forceinline__ void xcd_barrier_complete(unsigned* bar, unsigned x, unsigned G, unsigned& nloc, unsigned& nx) {
    unsigned sum, cnt, mine, sp = 0u;
    for (;;) {
        sum = 0u; cnt = 0u; mine = 0u;
#pragma unroll
        for (unsigned j = 0; j < 16; ++j) { const unsigned c = xb_ld(&bar[XB_XCNT(j)]); sum += c; cnt += (c > 0u) ? 1u : 0u; mine = (j == x) ? c : mine; }
        if (sum == G) break;
        __builtin_amdgcn_s_sleep(1);
        if ((++sp & 255u) == 0u) { if (xb_ld(&bar[XB_TMO])) break; if (sp > XB_SPIN_CAP) { atomicAdd(&bar[XB_TMO], 1u); break; } }
    }
    nloc = mine > 0u ? mine : 1u; nx = cnt > 0u ? cnt : 1u;
}
__device__ __forceinline__ void xcd_barrier(unsigned* bar, unsigned x, volatile LAS unsigned* st, unsigned G, int tid) {
    asm volatile("s_waitcnt vmcnt(0)" ::: "memory");
    __syncthreads();
    if (tid == 0) {
        __builtin_amdgcn_s_waitcnt(0);
        unsigned nloc = st[0], nx = st[1];
        if (nloc == 0u) { xcd_barrier_complete(bar, x, G, nloc, nx); st[0] = nloc; st[1] = nx; }
        const unsigned old = xb_add(&bar[XB_XSUB(x)], 1u);
        const unsigned gen = old / nloc;
        if (old + 1u == (gen + 1u) * nloc) {
            __builtin_amdgcn_fence(__ATOMIC_RELEASE, "agent");
            asm volatile("s_waitcnt vmcnt(0)" ::: "memory");
            const unsigned og = xb_add(&bar[XB_TOP], 1u);
            const unsigned tg = og / nx;
            if (og + 1u == (tg + 1u) * nx) xb_add(&bar[XB_TOPGEN], 1u);
            else XB_SPIN(xb_ld(&bar[XB_TOPGEN]) == tg, bar);
            __builtin_amdgcn_fence(__ATOMIC_ACQUIRE, "agent");
            xb_add(&bar[XB_XGEN(x)], 1u);
            asm volatile("s_waitcnt vmcnt(0)" ::: "memory");
        } else {
            XB_SPIN(xb_ld(&bar[XB_XGEN(x)]) == gen, bar);
            __builtin_amdgcn_fence(__ATOMIC_ACQUIRE, "agent");
            asm volatile("s_waitcnt vmcnt(0)" ::: "memory");
        }
    }
    __syncthreads();
}

struct Args { const float* in[21]; float* out; unsigned char* ws; int ph_lo, ph_hi; };

struct TrItem { f32x4 v[8]; float gv[8]; };
__device__ __forceinline__ void tr_load(TrItem& t, gfp W, int N, gfp gain, int item, int lane) {
    const int nblk = N / 32, kb = item / nblk, nb = item % nblk, k0 = 64 * kb, n0 = 32 * nb, r8 = lane >> 3, c4 = lane & 7;
    const GAS f32x4* src = (const GAS f32x4*)(W + (size_t)(k0 + r8) * N + n0) + c4;
#pragma unroll
    for (int i = 0; i < 8; ++i) t.v[i] = src[(size_t)i * 2 * N];
#pragma unroll
    for (int i = 0; i < 8; ++i) t.gv[i] = gain ? gain[k0 + 8 * i + r8] : 1.0f;
}
__device__ __forceinline__ void tr_store(const TrItem& t, int K, int N, bf16_t* WT, LAS float* scr, int item, int lane, bool ffn_perm) {
    const int nblk = N / 32, kb = item / nblk, nb = item % nblk, k0 = 64 * kb, n0 = 32 * nb, r8 = lane >> 3, c4 = lane & 7;
    int d0 = n0; if (ffn_perm) { const int bj = n0 / DFF, ff = n0 % DFF; d0 = 256 * (ff >> 7) + 128 * bj + (ff & 127); }
#pragma unroll
    for (int i = 0; i < 8; ++i) { LAS float* d = scr + (8 * i + r8) * 33 + 4 * c4; const f32x4 x = t.v[i] * t.gv[i]; d[0] = x[0]; d[1] = x[1]; d[2] = x[2]; d[3] = x[3]; }
    LDS_WAIT(); asm volatile("" ::: "memory");
    const int c = lane & 7;
#pragma unroll
    for (int j = 0; j < 4; ++j) { const int n = (lane >> 3) + 8 * j; const LAS float* s = scr + (8 * c) * 33 + n;
        u32x4 o; o.x = cvt_pk_bf16(s[0 * 33], s[1 * 33]); o.y = cvt_pk_bf16(s[2 * 33], s[3 * 33]); o.z = cvt_pk_bf16(s[4 * 33], s[5 * 33]); o.w = cvt_pk_bf16(s[6 * 33], s[7 * 33]);
        *(u32x4*)(WT + (size_t)(d0 + n) * K + k0 + 8 * c) = o; }
    LDS_WAIT(); asm volatile("" ::: "memory");
}
__device__ __forceinline__ void transpose_weight(gfp W, int K, int N, bf16_t* WT, gfp gain, LAS float* scr, int gw, int ngw, int lane, bool ffn_perm = false) {
    const int nitems = (K / 64) * (N / 32);
    if (gw >= nitems) return;
    TrItem a, b;
    tr_load(a, W, N, gain, gw, lane);
    for (int it = gw; it < nitems; it += 2 * ngw) {
        const int it1 = it + ngw, it2 = it + 2 * ngw;
        if (it1 < nitems) tr_load(b, W, N, gain, it1, lane);
        tr_store(a, K, N, WT, scr, it, lane, ffn_perm);
        if (it1 < nitems) { if (it2 < nitems) tr_load(a, W, N, gain, it2, lane); tr_store(b, K, N, WT, scr, it1, lane, ffn_perm); }
    }
}
__device__ __forceinline__ int t5_bucket(int rel) {
    const int n = rel < 0 ? -rel : rel; int b;
    if (n < 8) b = n; else if (n <= 14) b = 8; else if (n <= 26) b = 9; else if (n <= 49) b = 10; else if (n <= 90) b = 11;
    else if (n <= 165) b = 12; else if (n <= 304) b = 13; else if (n <= 558) b = 14; else b = 15;
    return b + (rel > 0 ? 16 : 0);
}
__device__ __forceinline__ void conv_fixup_tile(bf16_t* ACT, const float* EG, const float* EU, gfp cw, gfp cb, int pm, int tid) {
    constexpr int F4 = DFF / 4, NIT = 2 * F4;
    for (int it = tid; it < NIT; it += NTHREADS) {
        const int rem = it, e = rem / F4, f = (rem % F4) * 4;
        const f32x4 z = (f32x4){0.f, 0.f, 0.f, 0.f};
        f32x4 up, mid, dn, uu; int row;
        if (e == 0) { up = (pm & 15) == 0 ? z : *(const f32x4*)(EG + ((size_t)(pm - 1) * 4 + 3) * DFF + f); mid = *(const f32x4*)(EG + ((size_t)pm * 4 + 0) * DFF + f);
            dn = *(const f32x4*)(EG + ((size_t)pm * 4 + 1) * DFF + f); uu = *(const f32x4*)(EU + ((size_t)pm * 2 + 0) * DFF + f); row = pm * 256; }
        else { up = *(const f32x4*)(EG + ((size_t)pm * 4 + 2) * DFF + f); mid = *(const f32x4*)(EG + ((size_t)pm * 4 + 3) * DFF + f);
            dn = (pm & 15) == 15 ? z : *(const f32x4*)(EG + ((size_t)(pm + 1) * 4 + 0) * DFF + f); uu = *(const f32x4*)(EU + ((size_t)pm * 2 + 1) * DFF + f); row = pm * 256 + 255; }
        const f32x4 w0 = *(const GAS f32x4*)(cw + f), w1 = *(const GAS f32x4*)(cw + DFF + f), w2 = *(const GAS f32x4*)(cw + 2 * DFF + f), bb = *(const GAS f32x4*)(cb + f);
        const f32x4 a = w0 * up + w1 * mid + w2 * dn + bb;
        u32x2 ow; ow.x = cvt_pk_bf16(gelu_tanh(a[0]) * uu[0], gelu_tanh(a[1]) * uu[1]); ow.y = cvt_pk_bf16(gelu_tanh(a[2]) * uu[2], gelu_tanh(a[3]) * uu[3]);
        *(u32x2*)(ACT + (size_t)row * DFF + f) = ow;
    }
}

__global__ void __launch_bounds__(NTHREADS, 2) mk_fwd(Args args) {
    extern __shared__ __attribute__((aligned(16))) unsigned char lds[];
    const int wave0 = __builtin_amdgcn_readfirstlane((int)(threadIdx.x >> 6));
    const int G = gridDim.x, bx = blockIdx.x, ngw = G * NWAVES;
    const int vcu = (G % 8 == 0) ? (bx % 8) * (G / 8) + bx / 8 : bx;
#define PH_IDS const int tid = ltid(), lane = tid & 63, wave = __builtin_amdgcn_readfirstlane(tid >> 6), gw = bx * NWAVES + wave; LAS float* scr = (LAS float*)(ldsl + wave * 8704); (void)lane; (void)gw; (void)scr;
    unsigned char* ws = args.ws;
    const float* const* tab = (const float* const*)(ws + WS_TAB);
#define TAB(i) uni_ptr((gfp)__builtin_nontemporal_load(&tab[i]))
    float* H = args.out;
    float* ss = (float*)(ws + WS_SS);
    float* lse = (float*)(ws + WS_LSE);
    float* lut1 = (float*)(ws + WS_LUT1); float* lut2 = (float*)(ws + WS_LUT2); float* lut3 = (float*)(ws + WS_LUT3);
    bf16_t* Win = (bf16_t*)(ws + WS_WIN); bf16_t* Wout0 = (bf16_t*)(ws + WS_WOUT); bf16_t* Wout1 = (bf16_t*)(ws + WS_WIN + 18 * MiB);
    bf16_t* Wup = (bf16_t*)(ws + WS_WUP); bf16_t* Wdn = (bf16_t*)(ws + WS_WDN);
    bf16_t* R1 = (bf16_t*)(ws + WS_R1); bf16_t* R2 = (bf16_t*)(ws + WS_R2); bf16_t* BIG = (bf16_t*)(ws + WS_BIG);
    float* EG = (float*)(ws + WS_BIG + 192 * MiB); float* EU = EG + (size_t)64 * 4 * DFF;
    LAS unsigned char* ldsl = (LAS unsigned char*)lds;

    unsigned* barw = (unsigned*)(ws + WS_BAR); const unsigned xcc = xb_xcc_id();
    volatile LAS unsigned* bst = (volatile LAS unsigned*)(ldsl + LDS_BYTES - 64);
    { const int t0 = ltid(); if (t0 < 2) bst[t0] = 0u; if (t0 == 0) (void)xb_add(&barw[XB_XCNT(xcc)], 1u); }
    __syncthreads();
    const int lo = args.ph_lo, hi_ph = args.ph_hi;
#ifndef REP_MASK
#define REP_MASK 0
#endif
#define REPS(k) (((REP_MASK >> (k)) & 1) ? 2 : 1)
#ifndef PH_MASK
#define PH_MASK 0xffff
#endif
#define IN(k) (((PH_MASK >> (k)) & 1) && lo <= (k) && (k) < hi_ph)
#define SEAM2(a, b) do { if (IN(a) && IN(b)) { xcd_barrier(barw, xcc, bst, (unsigned)G, ltid()); } } while (0)
#define SEAM(k) SEAM2(k, (k) + 1)

    if (IN(0)) {
        PH_IDS
        gfp x = (gfp)args.in[0]; gfp ln_mix = (gfp)args.in[1]; gfp ln_ffn = (gfp)args.in[2]; gfp t5 = (gfp)args.in[4];
        gfp ev_w_in = (gfp)args.in[5]; gfp ev_w_out = (gfp)args.in[6]; gfp rpb = (gfp)args.in[16]; gfp w_up = (gfp)args.in[17]; gfp w_down = (gfp)args.in[20];
        if (bx == 0 && tid < 21) ((const float**)(ws + WS_TAB))[tid] = args.in[tid];
        if (bx == 0 && tid == 0) *(unsigned long long*)(ws + WS_TAB + 512) = *(const unsigned long long*)((const char*)__builtin_amdgcn_implicitarg_ptr() + 0x58);
        transpose_weight(ev_w_in, DM, EV_IN, Win, ln_mix, scr, gw, ngw, lane);
        for (int row = gw; row < MT; row += ngw) {
            const GAS f32x4* xr = (const GAS f32x4*)(x + (size_t)row * DM) + lane; u32x2* xo = (u32x2*)(R1 + (size_t)row * DM) + lane;
            float s = 0.f; f32x4 xv[8];
#pragma unroll
            for (int j = 0; j < 8; ++j) { xv[j] = xr[64 * j]; s += (xv[j][0] * xv[j][0] + xv[j][1] * xv[j][1]) + (xv[j][2] * xv[j][2] + xv[j][3] * xv[j][3]); }
            s = wave_sum(s);
            const float rs0 = __builtin_amdgcn_rsqf(s * (1.0f / DM) + RMS_EPS);
#pragma unroll
            for (int j = 0; j < 8; ++j) { const f32x4 v = xv[j] * rs0; u32x2 w; w.x = cvt_pk_bf16(v[0], v[1]); w.y = cvt_pk_bf16(v[2], v[3]); xo[64 * j] = w; }
            if (lane == 0) ss[row] = s;
        }
        for (int i = bx * NTHREADS + tid; i < 4 * MT; i += G * NTHREADS) ss[MT + i] = 0.f;
        const float inv_scale = 1.0f / ATT_SCALE;
        for (int i = bx * NTHREADS + tid; i < 4 * 2304; i += G * NTHREADS) { const int h = i / 2304, idx = i % 2304; const int rel = idx - 1024;
            lut1[i] = (idx <= 2048) ? t5[t5_bucket(rel) * 28 + 24 + h] * inv_scale : 0.f; }
        for (int i = bx * NTHREADS + tid; i < 24 * 1024; i += G * NTHREADS) { const int gh = i >> 10, idx = i & 1023, j = idx - 512, g = gh >> 3; const int dil = 1 << (2 * g);
            lut2[i] = (j >= -64 && j <= 64) ? t5[t5_bucket(dil * j) * 28 + gh] * inv_scale : -INFINITY; }
        for (int i = bx * NTHREADS + tid; i < 8 * 512; i += G * NTHREADS) { const int h = i >> 9, idx = i & 511;
            lut3[i] = (idx < 465) ? rpb[h * 465 + idx] * inv_scale : 0.f; }
    }
    SEAM(0);
    if (IN(1)) {
        pg8::Gemm g{R1, Win, MT, EV_IN, DM, DM}; pg8::StaticOrder S; S.init(MT, EV_IN, G, bx);
        pg8::EpiScaleBf16<false> E{BIG, EV_LD, ss, (LAS float*)(ldsl + 135168)};
        pg8::gemm_phase<pg8::EpiScaleBf16<false>, pg8::StaticOrder>(ldsl, g, S, E, ltid());
    }
    SEAM(1);
    if (IN(2)) {
        constexpr int NB_UNITS = 512, NA_UNITS = 1536;
        const int wslot2 = vcu & 7; int ucnt2 = 0;
#define P2_WEIGHTS() do { if (ucnt2++ == wslot2) { __syncthreads(); PH_IDS gfp ev_w_out = TAB(6); gfp w_up = TAB(17); gfp w_down = TAB(20); gfp ln_ffn = TAB(2); gfp od_w_in = TAB(12); gfp od_w_out = TAB(13); gfp ln_mix = TAB(1); \
            transpose_weight(ev_w_out, DM, DM, Wout0, nullptr, scr, gw, ngw, lane); transpose_weight(w_up, DM, DFF2, Wup, ln_ffn, scr, gw, ngw, lane, true); \
            transpose_weight(w_down, DFF, DM, Wdn, nullptr, scr, gw, ngw, lane); \
            transpose_weight(od_w_in, DM, OD_IN, Win, ln_mix + DM, scr, gw, ngw, lane); transpose_weight(od_w_out, DM, DM, Wout1, nullptr, scr, gw, ngw, lane); __syncthreads(); } } while (0)
        for (int idx = vcu; idx < NB_UNITS; idx += G) {
            att::AttnP P;
            {
                const int qblk = idx & 15, rest = idx >> 4, mp = rest & 1, h = (rest >> 1) & 3, b = rest >> 3;
                const bf16_t* base = BIG + (size_t)b * SEQ * EV_LD;
                P.Q = base + (size_t)(qblk * 256) * EV_LD + 9216 + h * 256 + mp * 128;
                P.K = base + 10240 + h * 256 + mp * 128; P.V = base + 11264 + h * 256;
                P.O = R2 + ((size_t)mp * MT + (size_t)b * SEQ + qblk * 256) * 1024 + h * 256;
                P.lse = nullptr; P.ldq = EV_LD; P.ldk = EV_LD; P.ldo = 1024; P.lse_ld = 0; P.NT = SEQ / 64;
                P.lut = lut1 + h * 2304; P.lut_n = 2304; P.lbase = 1024 - qblk * 256; P.krow0 = 0; P.qtok0 = 0; P.far_thr = 559; P.q0abs = qblk * 256; P.cidx = 1024;
                att::attn_unit_s<1, 2>(P, (char*)lds, ltid());
                P2_WEIGHTS();
            }
        }
        for (int i2 = vcu; i2 < NA_UNITS; i2 += G) {
            att::AttnP P;
            {
                const int sub = i2 & 15, rest = i2 >> 4, h = rest & 7, b = (rest >> 3) & 3, g = rest >> 5;
                const int dil = 1 << (2 * g), upc = 16 >> (2 * g), r = sub / upc, u = sub % upc, ntseg = (SEQ / dil) / 64;
                const int q0 = u * 256;
                int tb = q0 / 64 - 1; if (tb < 0) tb = 0; int te = q0 / 64 + 5; if (te > ntseg) te = ntseg;
                if ((te - tb) & 1) { if (tb > 0) --tb; else ++te; }
                const long ld = (long)dil * EV_LD;
                const bf16_t* base = BIG + ((size_t)b * SEQ + r) * EV_LD + g * 3072 + h * 128;
                P.Q = base + (size_t)q0 * ld; P.K = base + 1024 + (size_t)(tb * 64) * ld; P.V = base + 2048 + (size_t)(tb * 64) * ld;
                P.O = (bf16_t*)P.Q; P.ldq = ld; P.ldk = ld; P.ldo = ld;
                P.lse = lse + ((size_t)g * MT + (size_t)b * SEQ + r + (size_t)q0 * dil) * 8 + h; P.lse_ld = 8 * dil;
                P.NT = te - tb; P.lut = lut2 + (g * 8 + h) * 1024; P.lut_n = 1024; P.lbase = 512 - (q0 - tb * 64); P.krow0 = 0; P.qtok0 = 0; P.far_thr = 1 << 30; P.q0abs = 0; P.cidx = 0;
            }
            att::attn_unit_s<1, 1>(P, (char*)lds, ltid());
            P2_WEIGHTS();
        }
        while (ucnt2 <= wslot2) P2_WEIGHTS();
#undef P2_WEIGHTS
    }
    SEAM(2);
    if (IN(3)) {
        PH_IDS
        gfp lq1 = TAB(7); gfp lk1 = TAB(8); gfp lq2 = TAB(9); gfp lk2 = TAB(10); gfp subln = TAB(11);
        const f32x4 sl0 = *(const GAS f32x4*)(subln + (lane & 31) * 8), sl1 = *(const GAS f32x4*)(subln + (lane & 31) * 8 + 4);
        float a1 = lq1[lane] * lk1[lane] + lq1[lane + 64] * lk1[lane + 64], a2 = lq2[lane] * lk2[lane] + lq2[lane + 64] * lk2[lane + 64];
        a1 = wave_sum(a1); a2 = wave_sum(a2);
        const float lam = __expf(a1) - __expf(a2) + 0.2f;
        for (int row = gw; row < MT; row += ngw) {
            const bf16_t* pr = BIG + (size_t)row * EV_LD; bf16_t* mo = R1 + (size_t)row * DM;
#pragma unroll
            for (int j = 0; j < 2; ++j) {
                const int col = j * 512 + lane * 8, h = col >> 7;
                const float l0 = lse[((size_t)0 * MT + row) * 8 + h], l1 = lse[((size_t)1 * MT + row) * 8 + h], l2 = lse[((size_t)2 * MT + row) * 8 + h];
                const float mx = fmaxf(l0, fmaxf(l1, l2)); float e0 = __expf(l0 - mx), e1 = __expf(l1 - mx), e2 = __expf(l2 - mx);
                const float inv = 1.0f / (e0 + e1 + e2); e0 *= inv; e1 *= inv; e2 *= inv;
                const u32x4 o0 = *(const u32x4*)(pr + col), o1 = *(const u32x4*)(pr + 3072 + col), o2 = *(const u32x4*)(pr + 6144 + col);
                u32x4 w;
#pragma unroll
                for (int q = 0; q < 4; ++q) w[q] = cvt_pk_bf16(e0 * bf_lo(o0[q]) + e1 * bf_lo(o1[q]) + e2 * bf_lo(o2[q]), e0 * bf_hi(o0[q]) + e1 * bf_hi(o1[q]) + e2 * bf_hi(o2[q]));
                *(u32x4*)(mo + col) = w;
            }
#pragma unroll
            for (int j = 0; j < 2; ++j) {
                const int col = j * 512 + lane * 8, dv = (lane & 31) * 8;
                const u32x4 p1 = *(const u32x4*)(R2 + (size_t)row * 1024 + col), p2 = *(const u32x4*)(R2 + ((size_t)MT + row) * 1024 + col);
                float v[8]; float s = 0.f;
#pragma unroll
                for (int q = 0; q < 4; ++q) { v[2 * q] = bf_lo(p1[q]) - lam * bf_lo(p2[q]); v[2 * q + 1] = bf_hi(p1[q]) - lam * bf_hi(p2[q]); s += v[2 * q] * v[2 * q] + v[2 * q + 1] * v[2 * q + 1]; }
#pragma unroll
                for (int o = 1; o < 32; o <<= 1) s += __shfl_xor(s, o);
                const float rs = __builtin_amdgcn_rsqf(s * (1.0f / 256.0f) + RMS_EPS) * 0.8f;
                u32x4 w;
#pragma unroll
                for (int q = 0; q < 4; ++q) { const f32x4 sl = q < 2 ? sl0 : sl1; w[q] = cvt_pk_bf16(v[2 * q] * rs * sl[(2 * q) & 3], v[2 * q + 1] * rs * sl[(2 * q + 1) & 3]); }
                *(u32x4*)(mo + 1024 + col) = w;
            }
        }
    }
    SEAM(3);
    if (IN(4)) {
        pg8::Gemm g{R1, Wout0, MT, DM, DM, DM}; pg8::StaticOrder S; S.init(MT, DM, G, bx);
        gfp x = TAB(0);
        pg8::EpiResid<true, false> E{x, nullptr, nullptr, R2, ss + MT};
        pg8::gemm_phase<pg8::EpiResid<true, false>, pg8::StaticOrder>(ldsl, g, S, E, ltid());
    }
    SEAM(4);
    if (IN(5)) {
        pg8::Gemm g{R2, Wup, MT, DFF2, DM, DM}; pg8::StaticOrder S; S.init(MT, DFF2, G, bx);
        gfp conv_w = TAB(18); gfp conv_b = TAB(19);
        pg8::EpiConvGelu E{BIG, ss + MT, conv_w, conv_b, EG, EU, (LAS float*)(ldsl + 131072)};
        pg8::gemm_phase<pg8::EpiConvGelu, pg8::StaticOrder>(ldsl, g, S, E, ltid());
    }
    SEAM2(5, 7);
    if (IN(7)) {
        pg8::Gemm g{BIG, Wdn, MT, DM, DFF, DFF}; pg8::StaticOrder S; S.init(MT, DM, G, bx);
        { PH_IDS gfp conv_w = TAB(18); gfp conv_b = TAB(19); pg8::Unit u0; int lastpm = -1;
          for (int i = 0; S.next(i, u0); ++i) if (u0.pm != lastpm) { conv_fixup_tile(BIG, EG, EU, conv_w, conv_b, u0.pm, tid); lastpm = u0.pm; }
          asm volatile("s_waitcnt vmcnt(0)" ::: "memory"); __syncthreads(); }
        pg8::EpiResid<false, false> E{nullptr, R2, nullptr, R2, ss + 2 * MT};
        pg8::gemm_phase<pg8::EpiResid<false, false>, pg8::StaticOrder>(ldsl, g, S, E, ltid());
    }
    SEAM(7);
    if (IN(8)) {
        pg8::Gemm g{R2, Win, MT, OD_IN, DM, DM}; pg8::StaticOrder S; S.init(MT, OD_IN, G, bx);
        gfp qnorm = TAB(14); gfp knorm = TAB(15);
        pg8::EpiScaleRope E{BIG, OD_IN, ss + 2 * MT, (LAS float*)(ldsl + 135168), (LAS float*)(ldsl + 131072), qnorm, knorm};
        pg8::gemm_phase<pg8::EpiScaleRope, pg8::StaticOrder>(ldsl, g, S, E, ltid());
    }
    SEAM2(8, 10);
    if (IN(10)) {
        constexpr int NC_UNITS = 512, ND_UNITS = 512;
        const int wslot10 = vcu & 3; int ucnt10 = 0;
#define P10_WEIGHTS() do { if (ucnt10++ == wslot10) { __syncthreads(); PH_IDS gfp w_up = TAB(17); gfp w_down = TAB(20); gfp ln_ffn = TAB(2); \
            transpose_weight(w_up + (size_t)DM * DFF2, DM, DFF2, Wup, ln_ffn + DM, scr, gw, ngw, lane, true); \
            transpose_weight(w_down + (size_t)DFF * DM, DFF, DM, Wdn, nullptr, scr, gw, ngw, lane); __syncthreads(); } } while (0)
        for (int idx = vcu; idx < NC_UNITS; idx += G) {
            att::AttnP P; P.lse = nullptr; P.lse_ld = 0; P.ldq = OD_IN; P.ldk = OD_IN; P.ldo = DM; P.lbase = 0; P.krow0 = 0; P.qtok0 = 0; P.lut = nullptr; P.lut_n = 0; P.far_thr = 1 << 30; P.q0abs = 0; P.cidx = 0;
            {
                const int qblk = idx & 15, hq = (idx >> 4) & 7, b = idx >> 7;
                const bf16_t* base = BIG + (size_t)b * SEQ * OD_IN;
                P.Q = base + (size_t)(qblk * 256) * OD_IN + hq * 128; P.K = base + 1024 + (hq >> 2) * 128; P.V = base + 1280 + (hq >> 2) * 128;
                P.O = R1 + ((size_t)b * SEQ + qblk * 256) * DM + hq * 128; P.NT = SEQ / 64;
                if (ATT_EN & 1) att::attn_unit<0, 2, false>(P, (char*)lds, ltid());
                P10_WEIGHTS();
            }
        }
        for (int i2 = vcu; i2 < ND_UNITS; i2 += G) {
            att::AttnP P; P.lse = nullptr; P.lse_ld = 0; P.ldq = OD_IN; P.ldk = OD_IN; P.ldo = DM; P.lbase = 0; P.krow0 = 0; P.qtok0 = 0; P.lut = nullptr; P.lut_n = 0; P.far_thr = 1 << 30; P.q0abs = 0; P.cidx = 0;
            {
                const int u = i2 & 15, h = (i2 >> 4) & 7, b = i2 >> 7;
                const int krow0 = min(max(4 * u - 4, 0), 56), nt = (u == 0 || u == 15) ? 8 : 12;
                const bf16_t* base = BIG + (size_t)b * SEQ * OD_IN + 1536 + h * 128;
                P.Q = base + (size_t)(u * 256) * OD_IN; P.K = base + 1024 + (size_t)(krow0 * 64) * OD_IN; P.V = base + 2048 + (size_t)(krow0 * 64) * OD_IN;
                P.O = R1 + ((size_t)b * SEQ + u * 256) * DM + 1024 + h * 128; P.NT = nt;
                P.lut = lut3 + h * 512; P.lut_n = 512; P.krow0 = krow0; P.qtok0 = u * 256;
                att::attn_unit_s<3, 1>(P, (char*)lds, ltid());
                P10_WEIGHTS();
            }
        }
        while (ucnt10 <= wslot10) P10_WEIGHTS();
#undef P10_WEIGHTS
    }
    SEAM(10);
    if (IN(11)) {
        pg8::Gemm g{R1, Wout1, MT, DM, DM, DM}; pg8::StaticOrder S; S.init(MT, DM, G, bx);
        pg8::EpiResid<false, false> E{nullptr, R2, nullptr, R2, ss + 3 * MT};
        pg8::gemm_phase<pg8::EpiResid<false, false>, pg8::StaticOrder>(ldsl, g, S, E, ltid());
    }
    SEAM(11);
    if (IN(12)) {
        pg8::Gemm g{R2, Wup, MT, DFF2, DM, DM}; pg8::StaticOrder S; S.init(MT, DFF2, G, bx);
        gfp conv_w = TAB(18); gfp conv_b = TAB(19);
        pg8::EpiConvGelu E{BIG, ss + 3 * MT, conv_w + 3 * DFF, conv_b + DFF, EG, EU, (LAS float*)(ldsl + 131072)};
        pg8::gemm_phase<pg8::EpiConvGelu, pg8::StaticOrder>(ldsl, g, S, E, ltid());
    }
    SEAM2(12, 14);
    if (IN(14)) {
        pg8::Gemm g{BIG, Wdn, MT, DM, DFF, DFF}; pg8::StaticOrder S; S.init(MT, DM, G, bx);
        { PH_IDS gfp conv_w = TAB(18); gfp conv_b = TAB(19); pg8::Unit u0; int lastpm = -1;
          for (int i = 0; S.next(i, u0); ++i) if (u0.pm != lastpm) { conv_fixup_tile(BIG, EG, EU, conv_w + 3 * DFF, conv_b + DFF, u0.pm, tid); lastpm = u0.pm; }
          asm volatile("s_waitcnt vmcnt(0)" ::: "memory"); __syncthreads(); }
        pg8::EpiResid<false, true> E{nullptr, R2, H, nullptr, ss + 4 * MT};
        pg8::gemm_phase<pg8::EpiResid<false, true>, pg8::StaticOrder>(ldsl, g, S, E, ltid());
    }
    SEAM(14);
    if (IN(15)) {
        PH_IDS
        gfp ln_final = TAB(3);
        f32x4 gfin[8];
#pragma unroll
        for (int j = 0; j < 8; ++j) gfin[j] = ((const GAS f32x4*)ln_final)[64 * j + lane];
        for (int row = gw; row < MT; row += ngw) {
            f32x4* hr = (f32x4*)(H + (size_t)row * DM) + lane;
            const float rs = __builtin_amdgcn_rsqf(ss[4 * MT + row] * (1.0f / DM) + RMS_EPS);
            f32x4 hv[8];
#pragma unroll
            for (int j = 0; j < 8; ++j) hv[j] = hr[64 * j];
#pragma unroll
            for (int j = 0; j < 8; ++j) __builtin_nontemporal_store(hv[j] * rs * gfin[j], &hr[64 * j]);
        }
    }
#undef IN
#undef SEAM
}

extern "C" void kernel_launch(void* const* d_in, const int* in_sizes, int n_in, void* d_out, int out_size, void* d_ws, size_t ws_size, hipStream_t stream) {
    static int grid = 0;
    if (grid == 0) {
        if (n_in != 21 || out_size != MT * DM || ws_size < WS_END) { fprintf(stderr, "kernel_launch: unexpected shapes (n_in %d out %d ws %zu, need ws >= %zu)\n", n_in, out_size, ws_size, (size_t)WS_END); grid = -1; return; }
        int dev = 0, cus = 0, per_cu = 0;
        if (hipGetDevice(&dev) != hipSuccess || hipDeviceGetAttribute(&cus, hipDeviceAttributeMultiprocessorCount, dev) != hipSuccess) { grid = -1; return; }
        if (hipFuncSetAttribute((const void*)mk_fwd, hipFuncAttributeMaxDynamicSharedMemorySize, LDS_BYTES) != hipSuccess) { fprintf(stderr, "kernel_launch: hipFuncSetAttribute failed\n"); grid = -1; return; }
        if (hipOccupancyMaxActiveBlocksPerMultiprocessor(&per_cu, (const void*)mk_fwd, NTHREADS, LDS_BYTES) != hipSuccess || per_cu < 1) { fprintf(stderr, "kernel_launch: occupancy query says %d\n", per_cu); per_cu = 1; }
        (void)hipGetLastError();
        grid = cus * per_cu;
    }
    if (grid < 0) return;
    if (hipMemsetAsync((char*)d_ws + WS_BAR, 0, 16384, stream) != hipSuccess) { fprintf(stderr, "kernel_launch: memset failed\n"); return; }
    Args a{};
    for (int i = 0; i < 21; ++i) a.in[i] = (const float*)d_in[i];
    a.out = (float*)d_out; a.ws = (unsigned char*)d_ws;
#if MK_PER_PHASE
    for (int p = 0; p < NPHASES; ++p) { a.ph_lo = p; a.ph_hi = p + 1; hipLaunchKernelGGL(mk_fwd, dim3(grid), dim3(NTHREADS), LDS_BYTES, stream, a); }
#else
    a.ph_lo = 0; a.ph_hi = NPHASES;
    void* kargs[] = {&a};
    hipError_t e = hipLaunchCooperativeKernel((void*)mk_fwd, dim3(grid), dim3(NTHREADS), kargs, LDS_BYTES, stream);
    if (e != hipSuccess) fprintf(stderr, "cooperative launch failed: %s (grid %d)\n", hipGetErrorString(e), grid);
#endif
}
```

```cpp
#include <hip/hip_runtime.h>
#include <hip/hip_cooperative_groups.h>
#include <cstdio>
#include <cstdint>
namespace cg = cooperative_groups;

#ifndef MK_PER_PHASE
#define MK_PER_PHASE 0
#endif

#ifndef ATT_EN
#define ATT_EN 15
#endif
#define LAS __attribute__((address_space(3)))
#define GAS __attribute__((address_space(1)))
typedef const __attribute__((address_space(1))) float* gfp;
typedef unsigned short bf16_t;
typedef short bf16x8 __attribute__((ext_vector_type(8)));
typedef short s16x4 __attribute__((ext_vector_type(4)));
typedef float f32x4 __attribute__((ext_vector_type(4)));
typedef float f32x2 __attribute__((ext_vector_type(2)));
typedef float f32x16 __attribute__((ext_vector_type(16)));
typedef unsigned u32x4 __attribute__((ext_vector_type(4)));
typedef unsigned u32x2 __attribute__((ext_vector_type(2)));

constexpr int MT = 16384, SEQ = 4096, DM = 2048, NBATCH = 4;
constexpr int EV_IN = 12288, OD_IN = 4608, DFF = 5632, DFF2 = 11264;
constexpr int EV_LD = EV_IN + 64;
constexpr float RMS_EPS = 1e-6f;
constexpr float ATT_SCALE = 0.088388347648318440f;
constexpr int NWAVES = 8, NTHREADS = 512;
constexpr int LDS_BYTES = 147456;
constexpr int NPHASES = 16;

constexpr size_t MiB = 1u << 20;
constexpr size_t WS_SS = 0;
constexpr size_t WS_BAR = 384 * 1024;
constexpr size_t WS_TAB = 512 * 1024;
constexpr size_t WS_LSE = 1 * MiB;
constexpr size_t WS_LUT1 = 3 * MiB;
constexpr size_t WS_LUT2 = WS_LUT1 + 4 * 8192 * 4;
constexpr size_t WS_LUT3 = WS_LUT2 + 24 * 1024 * 4;
constexpr size_t WS_WIN = 4 * MiB;
constexpr size_t WS_WOUT = 52 * MiB;
constexpr size_t WS_WUP = 60 * MiB;
constexpr size_t WS_WDN = 104 * MiB;
constexpr size_t WS_R1 = 126 * MiB;
constexpr size_t WS_R2 = 190 * MiB;
constexpr size_t WS_BIG = 254 * MiB;
constexpr size_t WS_END = 642 * MiB;

__device__ __forceinline__ unsigned f2bf(float f) { unsigned u = __builtin_bit_cast(unsigned, f); return (u + 0x7fffu + ((u >> 16) & 1u)) >> 16; }
__device__ __forceinline__ unsigned cvt_pk_bf16(float lo, float hi) { unsigned r; asm volatile("v_cvt_pk_bf16_f32 %0, %1, %2" : "=v"(r) : "v"(lo), "v"(hi)); return r; }
__device__ __forceinline__ float bf_lo(unsigned w) { return __builtin_bit_cast(float, w << 16); }
__device__ __forceinline__ float bf_hi(unsigned w) { return __builtin_bit_cast(float, w & 0xffff0000u); }
__device__ __forceinline__ float wave_sum(float v) {
#pragma unroll
    for (int o = 1; o < 64; o <<= 1) v += __shfl_xor(v, o);
    return v;
}
__device__ __forceinline__ int ltid_(int wave0) { int z = 0; asm volatile("" : "+v"(z)); return wave0 * 64 + (int)__builtin_amdgcn_mbcnt_hi(~0u, __builtin_amdgcn_mbcnt_lo(~0u, (unsigned)z)); }
#define ltid() ltid_(wave0)
__device__ __forceinline__ gfp uni_ptr(gfp p) { const unsigned long long v = (unsigned long long)p; const unsigned lo = __builtin_amdgcn_readfirstlane((unsigned)v), hi = __builtin_amdgcn_readfirstlane((unsigned)(v >> 32)); return (gfp)(((unsigned long long)hi << 32) | lo); }
__device__ __forceinline__ unsigned dpp_xor1(unsigned v) { return (unsigned)__builtin_amdgcn_update_dpp(0, (int)v, 0xB1, 0xf, 0xf, false); }
__device__ __forceinline__ float dpp_xor1(float v) { return __int_as_float(__builtin_amdgcn_update_dpp(0, __float_as_int(v), 0xB1, 0xf, 0xf, false)); }
#define LDS_WAIT() asm volatile("s_waitcnt lgkmcnt(0)" ::: "memory")

__device__ __forceinline__ float gelu_tanh(float x) {
    constexpr float C1 = -2.0f * 1.4426950408889634f * 0.7978845608028654f, C2 = C1 * 0.044715f;
    const float e = __builtin_amdgcn_exp2f(x * fmaf(x * x, C2, C1));
    return x * __builtin_amdgcn_rcpf(1.0f + e);
}


namespace pg8 {
constexpr int BM = 256, BK = 64, HALF = 128, HTB = HALF * BK * 2, STAGE_BYTES = 8 * HTB, NXCD = 8, WGM = 8;
__host__ __device__ __forceinline__ int lds_byte(int r, int c) { const int st = (r >> 4) * 2 + (c >> 5), rr = r & 15, cc = c & 31, ob = rr * 64 + cc * 2; return st * 1024 + (ob ^ (((ob >> 9) & 1) << 5)); }
__host__ __device__ __forceinline__ void stage_rc(int b, int& R, int& C) { const int st = b / 1024, sb = b % 1024, swz = sb ^ (((sb >> 9) & 1) << 5); R = (st >> 1) * 16 + swz / 64; C = (st & 1) * 32 + (swz % 64) / 2; }
__host__ __device__ __forceinline__ int perm32(int rho) { const int n = rho >> 4, i = rho & 15; return 8 * (i >> 2) + 4 * n + (i & 3); }

struct Unit { int pm, pn; };
struct Gemm { const bf16_t* A; const bf16_t* Bt; int M, N, K, lda; };

struct StaticOrder {
    int nM, nN, nwg, G, c;
    __device__ __forceinline__ void init(int M, int N, int G_, int c_) { nM = M / BM; nN = N / BM; nwg = nM * nN; G = G_; c = c_; }
    __device__ __forceinline__ bool next(int i, Unit& u) const {
        const long L = (long)i * G + c; if (L >= nwg) return false;
        int wgid = (int)L; { const int q = nwg / NXCD, r = nwg % NXCD, xcd = wgid % NXCD, off = wgid / NXCD; wgid = (xcd < r ? xcd * (q + 1) : r * (q + 1) + (xcd - r) * q) + off; }
        const int nig = WGM * nN, gid = wgid / nig, fm = gid * WGM, gsz = (nM - fm) < WGM ? (nM - fm) : WGM;
        u.pm = fm + ((wgid % nig) % gsz); u.pn = (wgid % nig) / gsz; return true;
    }
};

__device__ __forceinline__ void store_pair_rows(bf16_t* O, size_t ldc, int row, int col0, int fr, u32x4 p0, u32x4 p1) {
    const bool odd = (fr & 1) != 0;
    const u32x4 snd = odd ? p0 : p1; u32x4 rcv;
    rcv.x = dpp_xor1(snd.x); rcv.y = dpp_xor1(snd.y); rcv.z = dpp_xor1(snd.z); rcv.w = dpp_xor1(snd.w);
    bf16_t* pa = O + (size_t)(row - (odd ? 1 : 0)) * ldc + col0 + (odd ? 8 : 0);
    *(u32x4*)pa = odd ? rcv : p0;
    *(u32x4*)(pa + ldc) = odd ? p1 : rcv;
}
template <bool SCALE>
struct EpiScaleBf16 {
    static constexpr int MAP = 2;
    bf16_t* O; int ldc; const float* ss; LAS float* RS;
    __device__ __forceinline__ void operator()(const f32x4 (&acc)[2][2][4][2], const Unit& u, int wr, int wc, int fr, int fq) const {
        if constexpr (SCALE) {
            const int tid = (wr * 4 + wc) * 64 + fq * 16 + fr;
            if (tid < 256) RS[tid] = __builtin_amdgcn_rsqf(ss[u.pm * BM + tid] * (1.0f / DM) + RMS_EPS);
            asm volatile("s_waitcnt vmcnt(0) lgkmcnt(0)" ::: "memory"); __builtin_amdgcn_s_barrier(); asm volatile("" ::: "memory");
        }
        const int lr0 = wr * 64 + fr, row0 = u.pm * BM + lr0, col0 = u.pn * BM + wc * 64 + 16 * fq;
#pragma unroll
        for (int ai = 0; ai < 2; ++ai)
#pragma unroll
            for (int m = 0; m < 4; ++m) {
                const int row = row0 + ai * HALF + m * 16;
                float rs = 1.0f; if constexpr (SCALE) rs = RS[lr0 + ai * HALF + m * 16];
                u32x4 pw[2];
#pragma unroll
                for (int bj = 0; bj < 2; ++bj) { const f32x4 v0 = acc[ai][bj][m][0] * rs, v1 = acc[ai][bj][m][1] * rs;
                    pw[bj].x = cvt_pk_bf16(v0[0], v0[1]); pw[bj].y = cvt_pk_bf16(v0[2], v0[3]); pw[bj].z = cvt_pk_bf16(v1[0], v1[1]); pw[bj].w = cvt_pk_bf16(v1[2], v1[3]); }
                store_pair_rows(O, (size_t)ldc, row, col0, fr, pw[0], pw[1]);
            }
    }
};
struct EpiScaleRope {
    static constexpr int MAP = 2;
    bf16_t* O; int ldc; const float* ss; LAS float* RS; LAS float* PS; gfp qn; gfp kn;
    __device__ __forceinline__ void operator()(f32x4 (&acc)[2][2][4][2], const Unit& u, int wr, int wc, int fr_in, int fq_in) const {
        (void)fr_in; (void)fq_in; int z_ = 0; asm volatile("" : "+v"(z_));
        const int lane_ = (int)__builtin_amdgcn_mbcnt_hi(~0u, __builtin_amdgcn_mbcnt_lo(~0u, (unsigned)z_)), fr = lane_ & 15, fq = lane_ >> 4;
        const int tid = (wr * 4 + wc) * 64 + fq * 16 + fr;
        if (tid < 256) RS[tid] = __builtin_amdgcn_rsqf(ss[u.pm * BM + tid] * (1.0f / DM) + RMS_EPS);
        asm volatile("s_waitcnt vmcnt(0) lgkmcnt(0)" ::: "memory"); __builtin_amdgcn_s_barrier(); asm volatile("" ::: "memory");
        const int lr0 = wr * 64 + fr, row0 = u.pm * BM + lr0, col0 = u.pn * BM + wc * 64 + 16 * fq;
#pragma unroll
        for (int ai = 0; ai < 2; ++ai)
#pragma unroll
            for (int m = 0; m < 4; ++m) { const float rs = RS[lr0 + ai * HALF + m * 16];
#pragma unroll
                for (int bj = 0; bj < 2; ++bj)
#pragma unroll
                    for (int n = 0; n < 2; ++n) acc[ai][bj][m][n] *= rs; }
        if (u.pn < 5) {
#pragma unroll
            for (int ai = 0; ai < 2; ++ai)
#pragma unroll
                for (int m = 0; m < 4; ++m) { float s = 0.f;
#pragma unroll
                    for (int bj = 0; bj < 2; ++bj)
#pragma unroll
                        for (int n = 0; n < 2; ++n) { const f32x4 v = acc[ai][bj][m][n]; s += (v[0] * v[0] + v[1] * v[1]) + (v[2] * v[2] + v[3] * v[3]); }
                    s += __shfl_xor(s, 16); s += __shfl_xor(s, 32);
                    if (fq == 0) PS[(lr0 + ai * HALF + m * 16) * 4 + wc] = s; }
            asm volatile("s_waitcnt lgkmcnt(0)" ::: "memory"); __builtin_amdgcn_s_barrier(); asm volatile("" ::: "memory");
            const gfp gsrc = (u.pn < 4) ? qn : kn; const int dbase = 64 * (wc & 1) + 16 * fq;
            f32x4 gg[2][2]; float invf[2][2][2];
#pragma unroll
            for (int bj = 0; bj < 2; ++bj)
#pragma unroll
                for (int n = 0; n < 2; ++n) { gg[bj][n] = *(const GAS f32x4*)(gsrc + dbase + 8 * bj + 4 * n);
#pragma unroll
                    for (int h = 0; h < 2; ++h) invf[bj][n][h] = __builtin_amdgcn_exp2f(-(float)(2 * (8 * fq + 4 * bj + 2 * n + h)) * (13.287712379549449f / 64.0f)); }
            const bool colaxis = (wc & 1) != 0;
#pragma unroll
            for (int ai = 0; ai < 2; ++ai)
#pragma unroll
                for (int m = 0; m < 4; ++m) { const int lr = lr0 + ai * HALF + m * 16;
                    const float tot = PS[lr * 4 + wc] + PS[lr * 4 + (wc ^ 1)]; const float r2 = __builtin_amdgcn_rsqf(tot * (1.0f / 128.0f) + RMS_EPS);
                    const int t = (row0 + ai * HALF + m * 16) & (SEQ - 1); const float pos = colaxis ? (float)(t & 63) : (float)(t >> 6);
                    u32x4 pw[2];
#pragma unroll
                    for (int bj = 0; bj < 2; ++bj) {
#pragma unroll
                        for (int n = 0; n < 2; ++n) { f32x4 v = acc[ai][bj][m][n] * r2 * gg[bj][n];
#pragma unroll
                            for (int h = 0; h < 2; ++h) { const float rev = pos * invf[bj][n][h] * 0.15915494309189535f; const float sn = __builtin_amdgcn_sinf(rev), cs = __builtin_amdgcn_cosf(rev); const float x0 = v[2 * h], x1 = v[2 * h + 1];
                                pw[bj][2 * n + h] = cvt_pk_bf16(x0 * cs - x1 * sn, x0 * sn + x1 * cs); } } }
                    store_pair_rows(O, (size_t)ldc, row0 + ai * HALF + m * 16, col0, fr, pw[0], pw[1]);
                    asm volatile("" ::: "memory"); }
        } else {
#pragma unroll
        for (int ai = 0; ai < 2; ++ai)
#pragma unroll
            for (int m = 0; m < 4; ++m) { u32x4 pw[2];
#pragma unroll
                for (int bj = 0; bj < 2; ++bj) { const f32x4 v0 = acc[ai][bj][m][0], v1 = acc[ai][bj][m][1];
                    pw[bj].x = cvt_pk_bf16(v0[0], v0[1]); pw[bj].y = cvt_pk_bf16(v0[2], v0[3]); pw[bj].z = cvt_pk_bf16(v1[0], v1[1]); pw[bj].w = cvt_pk_bf16(v1[2], v1[3]); }
                store_pair_rows(O, (size_t)ldc, row0 + ai * HALF + m * 16, col0, fr, pw[0], pw[1]); }
        }
    }
};
template <bool BASE_F32, bool OUT_F32>
struct EpiResid {
    static constexpr bool ALLBF = !BASE_F32 && !OUT_F32;
    static constexpr int MAP = ALLBF ? 2 : 1;
    gfp basef; const bf16_t* baseb; float* H; bf16_t* HB; float* ssn;
    __device__ __forceinline__ void operator()(const f32x4 (&acc)[2][2][4][2], const Unit& u, int wr, int wc, int fr, int fq) const {
        if constexpr (ALLBF) {
            const int row0 = u.pm * BM + wr * 64 + fr, col0 = u.pn * BM + wc * 64 + 16 * fq; const bool odd = (fr & 1) != 0;
#pragma unroll
            for (int ai = 0; ai < 2; ++ai)
#pragma unroll
                for (int m = 0; m < 4; ++m) {
                    const int row = row0 + ai * HALF + m * 16; float s = 0.f;
                    const bf16_t* pa = baseb + (size_t)(row - (odd ? 1 : 0)) * DM + col0 + (odd ? 8 : 0);
                    const u32x4 la = *(const u32x4*)pa, lb = *(const u32x4*)(pa + DM);
                    const u32x4 snd = odd ? la : lb; u32x4 rcv;
                    rcv.x = dpp_xor1(snd.x); rcv.y = dpp_xor1(snd.y); rcv.z = dpp_xor1(snd.z); rcv.w = dpp_xor1(snd.w);
                    const u32x4 bw0 = odd ? rcv : la, bw1 = odd ? lb : rcv;
                    u32x4 pw[2];
#pragma unroll
                    for (int bj = 0; bj < 2; ++bj) { const u32x4 bw = bj ? bw1 : bw0;
                        const f32x4 b0 = (f32x4){bf_lo(bw.x), bf_hi(bw.x), bf_lo(bw.y), bf_hi(bw.y)}, b1 = (f32x4){bf_lo(bw.z), bf_hi(bw.z), bf_lo(bw.w), bf_hi(bw.w)};
                        const f32x4 v0 = acc[ai][bj][m][0] + b0, v1 = acc[ai][bj][m][1] + b1;
                        pw[bj].x = cvt_pk_bf16(v0[0], v0[1]); pw[bj].y = cvt_pk_bf16(v0[2], v0[3]); pw[bj].z = cvt_pk_bf16(v1[0], v1[1]); pw[bj].w = cvt_pk_bf16(v1[2], v1[3]);
                        s += (v0[0] * v0[0] + v0[1] * v0[1]) + (v0[2] * v0[2] + v0[3] * v0[3]) + (v1[0] * v1[0] + v1[1] * v1[1]) + (v1[2] * v1[2] + v1[3] * v1[3]); }
                    store_pair_rows(HB, (size_t)DM, row, col0, fr, pw[0], pw[1]);
                    s += __shfl_xor(s, 16); s += __shfl_xor(s, 32);
                    if (fq == 0) unsafeAtomicAdd(ssn + row, s);
                }
        } else {
        const int row0 = u.pm * BM + wr * 64 + fr, col0 = u.pn * BM + wc * 32 + 8 * fq; const bool odd = (fr & 1) != 0;
#pragma unroll
        for (int ai = 0; ai < 2; ++ai)
#pragma unroll
            for (int m = 0; m < 4; ++m) {
                const int row = row0 + ai * HALF + m * 16; float s = 0.f;
                const size_t off = (size_t)row * DM + col0;
                const size_t offp = (size_t)(row - (odd ? 1 : 0)) * DM + col0 + (odd ? 4 : 0);
#pragma unroll
                for (int bj = 0; bj < 2; ++bj) {
                    f32x4 b0, b1;
                    if constexpr (BASE_F32) { const f32x4 la = *(const GAS f32x4*)(basef + offp + bj * HALF), lb = *(const GAS f32x4*)(basef + offp + DM + bj * HALF);
                        const f32x4 snd = odd ? la : lb; f32x4 rcv; rcv[0] = dpp_xor1(snd[0]); rcv[1] = dpp_xor1(snd[1]); rcv[2] = dpp_xor1(snd[2]); rcv[3] = dpp_xor1(snd[3]);
                        b0 = odd ? rcv : la; b1 = odd ? lb : rcv; }
                    else { const u32x4 bw = *(const u32x4*)(baseb + off + bj * HALF);
                        b0 = (f32x4){bf_lo(bw.x), bf_hi(bw.x), bf_lo(bw.y), bf_hi(bw.y)}; b1 = (f32x4){bf_lo(bw.z), bf_hi(bw.z), bf_lo(bw.w), bf_hi(bw.w)}; }
                    const f32x4 v0 = acc[ai][bj][m][0] + b0, v1 = acc[ai][bj][m][1] + b1;
                    if constexpr (OUT_F32) { const f32x4 snd = odd ? v0 : v1; f32x4 rcv; rcv[0] = dpp_xor1(snd[0]); rcv[1] = dpp_xor1(snd[1]); rcv[2] = dpp_xor1(snd[2]); rcv[3] = dpp_xor1(snd[3]);
                        *(f32x4*)(H + offp + bj * HALF) = odd ? rcv : v0; *(f32x4*)(H + offp + DM + bj * HALF) = odd ? v1 : rcv; }
                    else { u32x4 w; w.x = cvt_pk_bf16(v0[0], v0[1]); w.y = cvt_pk_bf16(v0[2], v0[3]); w.z = cvt_pk_bf16(v1[0], v1[1]); w.w = cvt_pk_bf16(v1[2], v1[3]);
                        *(u32x4*)(HB + off + bj * HALF) = w; }
                    s += (v0[0] * v0[0] + v0[1] * v0[1]) + (v0[2] * v0[2] + v0[3] * v0[3]) + (v1[0] * v1[0] + v1[1] * v1[1]) + (v1[2] * v1[2] + v1[3] * v1[3]);
                }
                s += __shfl_xor(s, 16); s += __shfl_xor(s, 32);
                if (fq == 0) unsafeAtomicAdd(ssn + row, s);
            }
        }
    }
};
__device__ __forceinline__ float dpp_ror1(float v) { return __int_as_float(__builtin_amdgcn_update_dpp(0, __float_as_int(v), 0x121, 0xf, 0xf, false)); }
__device__ __forceinline__ float dpp_rol1(float v) { return __int_as_float(__builtin_amdgcn_update_dpp(0, __float_as_int(v), 0x12F, 0xf, 0xf, false)); }
struct EpiConvGelu {
    static constexpr int MAP = 1;
    bf16_t* ACT; const float* ss; gfp cw; gfp cb; float* EG; float* EU; LAS float* X;
    __device__ __forceinline__ void operator()(f32x4 (&acc)[2][2][4][2], const Unit& u, int wr, int wc, int fr, int fq) const {
        const int lane = fr + 16 * fq;
        const int row0 = u.pm * BM + wr * 64 + fr, cl = wc * 32 + 8 * fq, f0 = u.pn * 128 + cl;
        LAS float* RS = X + 1024; LAS float* CW = X + 1280;
        { const int tid = (wr * 4 + wc) * 64 + lane;
          if (tid < 256) RS[tid] = __builtin_amdgcn_rsqf(ss[u.pm * BM + tid] * (1.0f / DM) + RMS_EPS);
          else if (tid < 384) { const int i = tid - 256, arr = i >> 5, f4 = i & 31;
              *(LAS f32x4*)(CW + arr * 128 + f4 * 4) = *(const GAS f32x4*)((arr < 3 ? cw + arr * DFF : cb) + u.pn * 128 + f4 * 4); } }
        asm volatile("s_waitcnt vmcnt(0) lgkmcnt(0)" ::: "memory"); __builtin_amdgcn_s_barrier(); asm volatile("" ::: "memory");
        f32x4 w0[2], w1[2], w2[2], bb[2];
#pragma unroll
        for (int n = 0; n < 2; ++n) { w0[n] = *(const LAS f32x4*)(CW + cl + 4 * n); w1[n] = *(const LAS f32x4*)(CW + 128 + cl + 4 * n); w2[n] = *(const LAS f32x4*)(CW + 256 + cl + 4 * n); bb[n] = *(const LAS f32x4*)(CW + 384 + cl + 4 * n); }
#pragma unroll
        for (int ai = 0; ai < 2; ++ai)
#pragma unroll
            for (int m = 0; m < 4; ++m) { const float rs = RS[wr * 64 + fr + ai * HALF + m * 16];
#pragma unroll
                for (int bj = 0; bj < 2; ++bj)
#pragma unroll
                    for (int n = 0; n < 2; ++n) acc[ai][bj][m][n] *= rs; }
        LAS float* XF = X; LAS float* XL = X + 4 * 128;
#pragma unroll
        for (int ai = 0; ai < 2; ++ai) { const int rb = 2 * ai + wr;
            if (fr == 0) { *(LAS f32x4*)(XF + rb * 128 + cl) = acc[ai][0][0][0]; *(LAS f32x4*)(XF + rb * 128 + cl + 4) = acc[ai][0][0][1]; }
            if (fr == 15) { *(LAS f32x4*)(XL + rb * 128 + cl) = acc[ai][0][3][0]; *(LAS f32x4*)(XL + rb * 128 + cl + 4) = acc[ai][0][3][1]; } }
        asm volatile("s_waitcnt lgkmcnt(0)" ::: "memory"); __builtin_amdgcn_s_barrier(); asm volatile("" ::: "memory");
#pragma unroll
        for (int ai = 0; ai < 2; ++ai) {
            const int rb = 2 * ai + wr;
            f32x4 Sprev[2], Scur[2], Tcur[2], Tnext[2];
#pragma unroll
            for (int n = 0; n < 2; ++n) { Sprev[n] = (rb > 0) ? *(const LAS f32x4*)(XL + (rb - 1) * 128 + cl + 4 * n) : (f32x4){0.f, 0.f, 0.f, 0.f};
#pragma unroll
                for (int j = 0; j < 4; ++j) Tcur[n][j] = dpp_rol1(acc[ai][0][0][n][j]); }
#pragma unroll
            for (int m = 0; m < 4; ++m) {
#pragma unroll
                for (int n = 0; n < 2; ++n) {
#pragma unroll
                    for (int j = 0; j < 4; ++j) Scur[n][j] = dpp_ror1(acc[ai][0][m][n][j]);
                    if (m < 3) {
#pragma unroll
                        for (int j = 0; j < 4; ++j) Tnext[n][j] = dpp_rol1(acc[ai][0][m < 3 ? m + 1 : 3][n][j]);
                    } else Tnext[n] = (rb < 3) ? *(const LAS f32x4*)(XF + (rb + 1) * 128 + cl + 4 * n) : (f32x4){0.f, 0.f, 0.f, 0.f};
                }
                const int row = row0 + ai * HALF + m * 16, lrow = row & 255;
                const bool edge = (lrow == 0) || (lrow == 255);
                u32x4 ow;
#pragma unroll
                for (int n = 0; n < 2; ++n) {
                    const f32x4 up = (fr == 0) ? Sprev[n] : Scur[n], dn = (fr == 15) ? Tnext[n] : Tcur[n];
                    const f32x4 a = w0[n] * up + w1[n] * acc[ai][0][m][n] + w2[n] * dn + bb[n];
                    const f32x4 uu = acc[ai][1][m][n];
                    ow[2 * n] = cvt_pk_bf16(gelu_tanh(a[0]) * uu[0], gelu_tanh(a[1]) * uu[1]);
                    ow[2 * n + 1] = cvt_pk_bf16(gelu_tanh(a[2]) * uu[2], gelu_tanh(a[3]) * uu[3]);
                }
                if (!edge) *(u32x4*)(ACT + (size_t)row * DFF + f0) = ow;
                if (lrow < 2 || lrow > 253) { const int e = lrow < 2 ? lrow : lrow - 252; float* eg = EG + ((size_t)u.pm * 4 + e) * DFF + f0;
                    *(f32x4*)eg = acc[ai][0][m][0]; *(f32x4*)(eg + 4) = acc[ai][0][m][1];
                    if (edge) { float* eu = EU + ((size_t)u.pm * 2 + (lrow == 255 ? 1 : 0)) * DFF + f0; *(f32x4*)eu = acc[ai][1][m][0]; *(f32x4*)(eu + 4) = acc[ai][1][m][1]; } }
#pragma unroll
                for (int n = 0; n < 2; ++n) { Sprev[n] = Scur[n]; Tcur[n] = Tnext[n]; }
            }
        }
    }
};

template <class Epi, class Sched, bool ALIGN_EPI = true, bool SP2 = true>
__device__ __forceinline__ void gemm_phase(LAS unsigned char* lds, const Gemm g, const Sched& S, const Epi& E, const int tid) {
    const int wid = __builtin_amdgcn_readfirstlane(tid >> 6), lane = tid & 63, wr = wid >> 2, wc = wid & 3, fr = lane & 15, fq = lane >> 4;
    const int K = g.K, nt = K / BK, lda = g.lda;
    unsigned voffA[2], voffB0[2], voffB1[2];
#pragma unroll
    for (int i = 0; i < 2; ++i) { int R, C; stage_rc(tid * 16 + i * 8192, R, C);
        voffA[i] = (unsigned)(R * lda + C) * 2u;
        if constexpr (Epi::MAP == 2) { const int wcR = R >> 5, rho = R & 31, nn = rho >> 4, ii = rho & 15, tr = 64 * wcR + 16 * (ii >> 2) + 4 * nn + (ii & 3);
            voffB0[i] = (unsigned)(tr * K + C) * 2u; voffB1[i] = (unsigned)((tr + 8) * K + C) * 2u; }
        else { const int Rb = (R & ~31) + perm32(R & 31); voffB0[i] = voffB1[i] = (unsigned)(Rb * K + C) * 2u; } }
    const size_t kstep = (size_t)(BK * 2);
    const size_t hstepA = (size_t)HALF * lda * 2, tstepA = 2 * hstepA, tstepB = (size_t)BM * K * 2;
    const size_t hstepB = (Epi::MAP == 2) ? (size_t)0 : (size_t)HALF * K * 2;
    const unsigned ldsw = (unsigned)wid * 1024u;
    const int aoff = lds_byte(wr * 64 + fr, fq * 8), boff = lds_byte(wc * 32 + fr, fq * 8);
#define PG8_SA(b, h) (((b) * 2 + (h)) * HTB)
#define PG8_SB(b, h) ((4 + (b) * 2 + (h)) * HTB)
#define PG8_STAGE(bufoff, gbase, voff) do { _Pragma("unroll") for (int _i = 0; _i < 2; ++_i) \
        __builtin_amdgcn_global_load_lds((const unsigned*)((const char*)(gbase) + (voff)[_i]), (LAS unsigned*)(lds + (bufoff) + ldsw + _i * 8192), 16, 0, 0); } while (0)
#define PG8_LDA(dst, b, h) do { _Pragma("unroll") for (int m = 0; m < 4; ++m) _Pragma("unroll") for (int k = 0; k < 2; ++k) dst[m][k] = *(const LAS bf16x8*)(lds + PG8_SA(b, h) + aoff + m * 2048 + k * 1024); } while (0)
#define PG8_LDB(dst, b, h) do { _Pragma("unroll") for (int n = 0; n < 2; ++n) _Pragma("unroll") for (int k = 0; k < 2; ++k) dst[n][k] = *(const LAS bf16x8*)(lds + PG8_SB(b, h) + boff + n * 2048 + k * 1024); } while (0)
#define PG8_MMA(ai, bj, At, Bt) do { __builtin_amdgcn_s_setprio(1); _Pragma("unroll") for (int m = 0; m < 4; ++m) _Pragma("unroll") for (int n = 0; n < 2; ++n) _Pragma("unroll") for (int k = 0; k < 2; ++k) \
        acc[ai][bj][m][n] = __builtin_amdgcn_mfma_f32_16x16x32_bf16(Bt[n][k], At[m][k], acc[ai][bj][m][n], 0, 0, 0); __builtin_amdgcn_s_setprio(0); } while (0)
#define PG8_WAIT_V(n) asm volatile("s_waitcnt vmcnt(" #n ")" ::: "memory")
#define PG8_WAIT_L(n) asm volatile("s_waitcnt lgkmcnt(" #n ")" ::: "memory")
#define PG8_BAR __builtin_amdgcn_s_barrier()
#define PG8_SCHED __builtin_amdgcn_sched_barrier(0)
    Unit cur, nxt; int ui = 0;
    if (!S.next(0, cur)) return;
    f32x4 acc[2][2][4][2];
#pragma unroll
    for (int a = 0; a < 2; ++a)
#pragma unroll
        for (int b = 0; b < 2; ++b)
#pragma unroll
            for (int m = 0; m < 4; ++m)
#pragma unroll
                for (int n = 0; n < 2; ++n) acc[a][b][m][n] = (f32x4){0.f, 0.f, 0.f, 0.f};
    bf16x8 At[4][2], B0[2][2], B1[2][2];
    const char* cA = (const char*)g.A + (size_t)cur.pm * tstepA; const char* cB = (const char*)g.Bt + (size_t)cur.pn * tstepB;
    static_assert(SP2, "only the SP2 loop is kept");
    PG8_STAGE(PG8_SB(0, 0), cB, voffB0); PG8_STAGE(PG8_SB(0, 1), cB + hstepB, voffB1); PG8_STAGE(PG8_SA(0, 0), cA, voffA); PG8_STAGE(PG8_SA(0, 1), cA + hstepA, voffA);
    if (wr == 1) PG8_BAR;
    PG8_WAIT_V(2); PG8_BAR;
    PG8_STAGE(PG8_SB(1, 0), cB + kstep, voffB0); PG8_STAGE(PG8_SA(1, 0), cA + kstep, voffA); PG8_STAGE(PG8_SB(1, 1), cB + hstepB + kstep, voffB1);
    PG8_WAIT_V(6); PG8_BAR;
    for (;;) {
        const bool has_next = S.next(ui + 1, nxt);
        const char* nA = has_next ? (const char*)g.A + (size_t)nxt.pm * tstepA : cA; const char* nB = has_next ? (const char*)g.Bt + (size_t)nxt.pn * tstepB : cB;
        for (int t = 0; t < nt; t += 2) {
            const bool last = (t == nt - 2);
            const char* a1 = cA + (size_t)(t + 1) * kstep;
            const char* a2 = last ? nA : cA + (size_t)(t + 2) * kstep; const char* b2 = last ? nB : cB + (size_t)(t + 2) * kstep;
            const char* a3 = a2 + kstep; const char* b3 = b2 + kstep;
            PG8_LDB(B0, 0, 0); PG8_LDB(B1, 0, 1); PG8_SCHED; PG8_LDA(At, 0, 0); PG8_STAGE(PG8_SA(1, 1), a1 + hstepA, voffA);
            PG8_WAIT_V(8); PG8_WAIT_L(0); PG8_BAR; PG8_MMA(0, 0, At, B0); PG8_MMA(0, 1, At, B1); PG8_BAR; PG8_SCHED;
            PG8_LDA(At, 0, 1); PG8_STAGE(PG8_SB(0, 0), b2, voffB0); PG8_STAGE(PG8_SB(0, 1), b2 + hstepB, voffB1); PG8_STAGE(PG8_SA(0, 0), a2, voffA);
            PG8_WAIT_V(8); PG8_WAIT_L(0); PG8_BAR; PG8_MMA(1, 0, At, B0); PG8_MMA(1, 1, At, B1); PG8_BAR; PG8_SCHED;
            PG8_LDB(B0, 1, 0); PG8_LDB(B1, 1, 1); PG8_SCHED; PG8_LDA(At, 1, 0); PG8_STAGE(PG8_SA(0, 1), a2 + hstepA, voffA);
            PG8_WAIT_V(8); PG8_WAIT_L(0); PG8_BAR; PG8_MMA(0, 0, At, B0); PG8_MMA(0, 1, At, B1); PG8_BAR; PG8_SCHED;
            PG8_LDA(At, 1, 1); PG8_STAGE(PG8_SB(1, 0), b3, voffB0); PG8_STAGE(PG8_SB(1, 1), b3 + hstepB, voffB1); PG8_STAGE(PG8_SA(1, 0), a3, voffA);
            PG8_WAIT_V(8); PG8_WAIT_L(0); PG8_BAR; PG8_MMA(1, 0, At, B0); PG8_MMA(1, 1, At, B1); PG8_BAR; PG8_SCHED;
        }
        if constexpr (ALIGN_EPI) { if (wr == 0) PG8_BAR; }
        E(acc, cur, wr, wc, fr, fq);
        if (!has_next) break;
#pragma unroll
        for (int a = 0; a < 2; ++a)
#pragma unroll
            for (int b = 0; b < 2; ++b)
#pragma unroll
                for (int m = 0; m < 4; ++m)
#pragma unroll
                    for (int n = 0; n < 2; ++n) acc[a][b][m][n] = (f32x4){0.f, 0.f, 0.f, 0.f};
        cur = nxt; cA = nA; cB = nB; ++ui;
        if constexpr (ALIGN_EPI) { if (wr == 1) PG8_BAR; }
    }
    PG8_WAIT_V(0);
    if constexpr (!ALIGN_EPI) { if (wr == 0) PG8_BAR; }
    PG8_BAR;
#undef PG8_SA
#undef PG8_SB
#undef PG8_STAGE
#undef PG8_LDA
#undef PG8_LDB
#undef PG8_MMA
#undef PG8_WAIT_V
#undef PG8_WAIT_L
#undef PG8_BAR
#undef PG8_SCHED
}
}

namespace att {
constexpr int D = 128, QBLK = 32, KVBLK = 64;
constexpr float SCALE = ATT_SCALE;
constexpr float THR = 8.f;
constexpr int SHM_V = KVBLK * D * 2, SHM_K = KVBLK * D * 2;
constexpr int LUT_OFF = 69632;
constexpr int QL_OFF = 102400;
#define KSWZ(row, colB) ((row) * 256 + ((colB) ^ (((row) & 7) << 4)))
#define SBAR() __builtin_amdgcn_sched_barrier(0)
__device__ __forceinline__ int crow(int r, int hi) { return (r & 3) + 8 * (r >> 2) + 4 * hi; }

struct AttnP {
    const bf16_t* Q; const bf16_t* K; const bf16_t* V; bf16_t* O; float* lse;
    long ldq, ldk, ldo; int lse_ld;
    int NT;
    const float* lut; int lut_n;
    int lbase;
    int krow0, qtok0;
    int far_thr, q0abs, cidx;
};

__device__ __forceinline__ void partialSM(f32x16& p0, f32x16& p1, float& m_reg, float& mn, float& alpha, const float cb = 0.f) {
    constexpr float C = SCALE * 1.4426950408889634f;
    float pmax = p0[0];
#pragma unroll
    for (int r = 1; r < 16; ++r) pmax = fmaxf(pmax, p0[r]);
#pragma unroll
    for (int r = 0; r < 16; ++r) pmax = fmaxf(pmax, p1[r]);
    { auto rr = __builtin_amdgcn_permlane32_swap(__float_as_uint(pmax), __float_as_uint(pmax), false, false);
      pmax = fmaxf(__uint_as_float(rr[0]), __uint_as_float(rr[1])) + cb; }
    if (__builtin_expect(__all(pmax - m_reg <= THR / SCALE), 1)) { mn = m_reg; alpha = 1.f; }
    else { mn = fmaxf(m_reg, pmax); alpha = __builtin_amdgcn_exp2f((m_reg - mn) * C); m_reg = mn; }
    float mnC = (cb - mn) * C;
#pragma unroll
    for (int r = 0; r < 16; ++r) p0[r] = fmaf(p0[r], C, mnC);
#pragma unroll
    for (int r = 0; r < 16; ++r) p1[r] = fmaf(p1[r], C, mnC);
#pragma unroll
    for (int r = 0; r < 16; ++r) p0[r] = __builtin_amdgcn_exp2f(p0[r]);
}
__device__ __forceinline__ void finishSM(f32x16& p0, f32x16& p1, float alpha, float& l_reg, bf16x8& pa0, bf16x8& pa1, bf16x8& pa2, bf16x8& pa3) {
#pragma unroll
    for (int r = 0; r < 16; ++r) p1[r] = __builtin_amdgcn_exp2f(p1[r]);
    float ps = 0;
#pragma unroll
    for (int r = 0; r < 16; ++r) ps += p0[r];
#pragma unroll
    for (int r = 0; r < 16; ++r) ps += p1[r];
    { auto rr = __builtin_amdgcn_permlane32_swap(__float_as_uint(ps), __float_as_uint(ps), false, false);
      ps = __uint_as_float(rr[0]) + __uint_as_float(rr[1]); }
    l_reg = l_reg * alpha + ps;
#define PK4(P, BASE, OUT) do { unsigned a0 = cvt_pk_bf16(P[BASE + 0], P[BASE + 1]), a1 = cvt_pk_bf16(P[BASE + 2], P[BASE + 3]);   \
    unsigned b0 = cvt_pk_bf16(P[BASE + 4], P[BASE + 5]), b1 = cvt_pk_bf16(P[BASE + 6], P[BASE + 7]);                              \
    auto r0 = __builtin_amdgcn_permlane32_swap(a0, b0, false, false); auto r1 = __builtin_amdgcn_permlane32_swap(a1, b1, false, false); \
    u32x4 w = {r0[0], r1[0], r0[1], r1[1]}; OUT = *reinterpret_cast<bf16x8*>(&w); } while (0)
    PK4(p0, 0, pa0); PK4(p0, 8, pa1); PK4(p1, 0, pa2); PK4(p1, 8, pa3);
#undef PK4
}
template <bool QL>
__device__ __forceinline__ void qkt(f32x16& p0, f32x16& p1, const char* Ks, const bf16x8* qr, const LAS char* qlds, int r32, int hi) {
    p0 = f32x16{}; p1 = f32x16{};
#pragma unroll
    for (int d0 = 0; d0 < 8; ++d0) { int cb = (d0 * 16 + hi * 8) * 2;
        bf16x8 b0 = *reinterpret_cast<const bf16x8*>(Ks + KSWZ(r32, cb));
        bf16x8 b1 = *reinterpret_cast<const bf16x8*>(Ks + KSWZ(32 + r32, cb));
        bf16x8 q;
        if constexpr (QL) { if (d0 < 4) q = qr[d0]; else q = *(const volatile LAS bf16x8*)(qlds + (d0 - 4) * 1024); } else q = qr[d0];
        p0 = __builtin_amdgcn_mfma_f32_32x32x16_bf16(b0, q, p0, 0, 0, 0);
        p1 = __builtin_amdgcn_mfma_f32_32x32x16_bf16(b1, q, p1, 0, 0, 0); }
}
__device__ __forceinline__ int v_st(int k, int c) { const int kk = (k & ~0xC) | ((k & 4) << 1) | ((k & 8) >> 1); return ((kk >> 3) * 4 + (c >> 5)) * 512 + ((kk & 7) * 32 + (c & 31)) * 2; }
__device__ __forceinline__ int v_rd_base(int lane) { return ((lane & 3) << 3) | (((lane >> 2) & 3) << 6) | (((lane >> 4) & 1) << 5) | (((lane >> 5) & 1) << 8); }
constexpr int v_rd_off(int d0, int ks, int half) { return d0 * 512 + ks * 4096 + half * 2048; }
template <int OFF> __device__ __forceinline__ s16x4 tr_read(int vb) {
    s16x4 r; asm volatile("ds_read_b64_tr_b16 %0, %1 offset:%2" : "=&v"(r) : "v"(vb), "i"(OFF) : "memory"); return r;
}
template <int D0> __device__ __forceinline__ void pv_one(f32x16& od, int vb, bf16x8 pa0, bf16x8 pa1, bf16x8 pa2, bf16x8 pa3) {
    const s16x4 l0 = tr_read<v_rd_off(D0, 0, 0)>(vb), h0 = tr_read<v_rd_off(D0, 0, 1)>(vb), l1 = tr_read<v_rd_off(D0, 1, 0)>(vb), h1 = tr_read<v_rd_off(D0, 1, 1)>(vb);
    const s16x4 l2 = tr_read<v_rd_off(D0, 2, 0)>(vb), h2 = tr_read<v_rd_off(D0, 2, 1)>(vb), l3 = tr_read<v_rd_off(D0, 3, 0)>(vb), h3 = tr_read<v_rd_off(D0, 3, 1)>(vb);
    asm volatile("s_waitcnt lgkmcnt(0)" ::: "memory"); SBAR();
#define PK(L, H) (bf16x8){L[0], L[1], L[2], L[3], H[0], H[1], H[2], H[3]}
    od = __builtin_amdgcn_mfma_f32_32x32x16_bf16(pa0, PK(l0, h0), od, 0, 0, 0);
    od = __builtin_amdgcn_mfma_f32_32x32x16_bf16(pa1, PK(l1, h1), od, 0, 0, 0);
    od = __builtin_amdgcn_mfma_f32_32x32x16_bf16(pa2, PK(l2, h2), od, 0, 0, 0);
    od = __builtin_amdgcn_mfma_f32_32x32x16_bf16(pa3, PK(l3, h3), od, 0, 0, 0);
#undef PK
}
__device__ __forceinline__ void pv_d0(f32x16* o, int vb, bf16x8 pa0, bf16x8 pa1, bf16x8 pa2, bf16x8 pa3) {
    pv_one<0>(o[0], vb, pa0, pa1, pa2, pa3); pv_one<1>(o[1], vb, pa0, pa1, pa2, pa3); pv_one<2>(o[2], vb, pa0, pa1, pa2, pa3); pv_one<3>(o[3], vb, pa0, pa1, pa2, pa3);
}

struct ModeCtx { int lidx; int rs, cs, qi, qj; int krow0; int far_thr, qlo; float cpos, cneg; };
template <int MODE> __device__ __forceinline__ float apply_mode(f32x16& p0, f32x16& p1, int t, const ModeCtx& c, const LAS float* lut, int hi) {
    float cb = 0.f;
    if constexpr (MODE == 1 || MODE == 2) {
        const int klo = t * 64;
        if (klo - (c.qlo + 31) >= c.far_thr) cb = c.cpos;
        else if (c.qlo - (klo + 63) >= c.far_thr) cb = c.cneg;
        else {
        const LAS float* L = lut + (c.lidx + t * 64);
#pragma unroll
        for (int g = 0; g < 4; ++g) {
            float b0[4], b1[4];
#pragma unroll
            for (int q = 0; q < 4; ++q) { b0[q] = L[8 * g + q]; b1[q] = L[32 + 8 * g + q]; }
#pragma unroll
            for (int q = 0; q < 4; ++q) { p0[4 * g + q] += b0[q]; p1[4 * g + q] += b1[q]; }
        }
        }
    } else if constexpr (MODE == 3) {
        const int ki = c.krow0 + t;
        const bool rowok = (unsigned)(ki - c.rs) < 8u;
        const int base = (ki - c.qi + 7) * 31 + 15 - c.qj + 4 * hi;
        const int kjb = 4 * hi - c.cs;
#pragma unroll
        for (int r = 0; r < 16; ++r) {
            const int kj0 = (r & 3) + 8 * (r >> 2);
            const bool ok0 = rowok && ((unsigned)(kjb + kj0) < 16u), ok1 = rowok && ((unsigned)(kjb + kj0 + 32) < 16u);
            const float v0 = lut[ok0 ? base + kj0 : 0], v1 = lut[ok1 ? base + kj0 + 32 : 0];
            p0[r] = ok0 ? p0[r] + v0 : -INFINITY; p1[r] = ok1 ? p1[r] + v1 : -INFINITY;
        }
    }
    return cb;
}

template <int MODE, int SDEPTH, bool QL>
__device__ __forceinline__ void attn_unit(const AttnP& P, char* lds, const int tid) {
    const int wid = tid >> 6, lane = tid & 63, r32 = lane & 31, hi = lane >> 5;
    char* V_lds = lds; char* K_lds = lds + 2 * SHM_V;
    float* ws = (float*)(lds + 2 * SHM_V + 2 * SHM_K) + wid * 64; float* li_l = ws; float* al_l = ws + 32;
    const LAS float* lut = (const LAS float*)((LAS char*)lds + LUT_OFF);
    __syncthreads();
    if constexpr (MODE != 0) { for (int i = tid; i < P.lut_n; i += NTHREADS) ((LAS float*)lut)[i] = P.lut[i]; }
    ModeCtx mc; mc.lidx = 0; mc.rs = mc.cs = mc.qi = mc.qj = 0; mc.krow0 = P.krow0; mc.far_thr = P.far_thr; mc.qlo = P.q0abs + wid * QBLK; mc.cpos = 0.f; mc.cneg = 0.f;
    if constexpr (MODE == 1 || MODE == 2) mc.lidx = P.lbase - (wid * QBLK + r32) + 4 * hi;
    if constexpr (MODE == 3) { const int tq = P.qtok0 + wid * QBLK + r32; mc.qi = tq >> 6; mc.qj = tq & 63;
        mc.rs = min(max(mc.qi - 4, 0), 56); mc.cs = min(max(mc.qj - 8, 0), 48); }
    float m_reg = -1e30f, l_reg = 0; f32x16 o[4] = {}; bf16x8 qr[QL ? 4 : 8];
    const LAS char* qlds = (const LAS char*)lds + QL_OFF + wid * 4096 + lane * 16;
    const bf16_t* Qw = P.Q + (long)(wid * QBLK + r32) * P.ldq + hi * 8;
#pragma unroll
    for (int d0 = 0; d0 < 8; ++d0) { const bf16x8 qv = *reinterpret_cast<const bf16x8*>(Qw + d0 * 16);
        if (QL && d0 >= 4) *(LAS bf16x8*)((LAS char*)qlds + (d0 - 4) * 1024) = qv; else qr[d0 < (QL ? 4 : 8) ? d0 : 0] = qv; }
    const int sr = tid >> 4, sc = (tid & 15) * 8, vst0 = v_st(sr, sc), vst1 = v_st(32 + sr, sc);
    const int vb0 = (int)(uintptr_t)V_lds + v_rd_base(lane);
    const bf16_t* Kh = P.K; const bf16_t* Vh = P.V; const long LDK = P.ldk;
    struct { bf16x8 vs0, vs1, ks0, ks1; } sr_[SDEPTH];
    const unsigned goff0 = (unsigned)((sr * LDK + sc) * 2), goff1 = (unsigned)(((32 + sr) * LDK + sc) * 2);
#define SLOAD(i, k0) do { const char* kb_ = (const char*)Kh + (size_t)(k0) * (size_t)LDK * 2; const char* vb_ = (const char*)Vh + (size_t)(k0) * (size_t)LDK * 2; \
    sr_[i].vs0 = *(const bf16x8*)(vb_ + goff0); sr_[i].vs1 = *(const bf16x8*)(vb_ + goff1); \
    sr_[i].ks0 = *(const bf16x8*)(kb_ + goff0); sr_[i].ks1 = *(const bf16x8*)(kb_ + goff1); } while (0)
#define SWRITE(b, i) do { *(bf16x8*)(V_lds + (b) * SHM_V + vst0) = sr_[i].vs0;          \
    *(bf16x8*)(V_lds + (b) * SHM_V + vst1) = sr_[i].vs1; int kc = sc * 2;               \
    *(bf16x8*)(K_lds + (b) * SHM_K + KSWZ(sr, kc)) = sr_[i].ks0;                       \
    *(bf16x8*)(K_lds + (b) * SHM_K + KSWZ(32 + sr, kc)) = sr_[i].ks1; } while (0)
#define SWAIT() do { if constexpr (SDEPTH == 2) asm volatile("s_waitcnt vmcnt(4)" ::: "memory"); else asm volatile("s_waitcnt vmcnt(0)" ::: "memory"); } while (0)
#define RESC(a) do { if (__any((a) < 1.f)) { if (hi == 0) al_l[r32] = (a); asm volatile("s_waitcnt lgkmcnt(0)" ::: "memory"); \
    _Pragma("unroll") for (int d = 0; d < 4; ++d) _Pragma("unroll") for (int r = 0; r < 16; ++r) o[d][r] *= al_l[crow(r, hi)]; } } while (0)
    f32x16 pA0, pA1, pB0, pB1; float mnA, mnB, alA, alB; bf16x8 pa0, pa1, pa2, pa3; const int NT = P.NT;
    constexpr int SE = 0, SO = SDEPTH - 1;
    SLOAD(SE, 0); asm volatile("s_waitcnt vmcnt(0)" ::: "memory"); SWRITE(0, SE); __syncthreads();
    if constexpr (MODE == 1) { if (P.far_thr < (1 << 20)) { mc.cpos = lut[P.cidx + P.far_thr]; mc.cneg = lut[P.cidx - P.far_thr]; } }
    qkt<QL>(pA0, pA1, K_lds, qr, qlds, r32, hi); { const float cb_ = apply_mode<MODE>(pA0, pA1, 0, mc, lut, hi); partialSM(pA0, pA1, m_reg, mnA, alA, cb_); }
    SLOAD(SO, KVBLK); if constexpr (SDEPTH == 2) { if (2 < NT) SLOAD(SE, 2 * KVBLK); }
    SWAIT(); SWRITE(1, SO); __syncthreads();
    for (int j = 1; j + 1 < NT; j += 2) {
        SBAR(); qkt<QL>(pB0, pB1, K_lds + SHM_K, qr, qlds, r32, hi);
        finishSM(pA0, pA1, alA, l_reg, pa0, pa1, pa2, pa3); SBAR();
        SLOAD(SO, (j + SDEPTH) * KVBLK); SBAR();
        pv_d0(o, vb0, pa0, pa1, pa2, pa3); { const float cb_ = apply_mode<MODE>(pB0, pB1, j, mc, lut, hi); partialSM(pB0, pB1, m_reg, mnB, alB, cb_); }
        __syncthreads(); SWAIT(); SWRITE(0, SE);
        RESC(alB); __syncthreads();
        SBAR(); qkt<QL>(pA0, pA1, K_lds, qr, qlds, r32, hi);
        finishSM(pB0, pB1, alB, l_reg, pa0, pa1, pa2, pa3); SBAR();
        if (SDEPTH == 1 || j + 3 < NT) SLOAD(SE, (j + 1 + SDEPTH) * KVBLK); SBAR();
        pv_d0(o, vb0 + SHM_V, pa0, pa1, pa2, pa3); { const float cb_ = apply_mode<MODE>(pA0, pA1, j + 1, mc, lut, hi); partialSM(pA0, pA1, m_reg, mnA, alA, cb_); }
        __syncthreads(); SWAIT(); SWRITE(1, SO);
        RESC(alA); __syncthreads();
    }
    SBAR(); qkt<QL>(pB0, pB1, K_lds + SHM_K, qr, qlds, r32, hi);
    finishSM(pA0, pA1, alA, l_reg, pa0, pa1, pa2, pa3); SBAR();
    pv_d0(o, vb0, pa0, pa1, pa2, pa3); { const float cb_ = apply_mode<MODE>(pB0, pB1, NT - 1, mc, lut, hi); partialSM(pB0, pB1, m_reg, mnB, alB, cb_); }
    __syncthreads(); RESC(alB);
    finishSM(pB0, pB1, alB, l_reg, pa0, pa1, pa2, pa3); SBAR();
    pv_d0(o, vb0 + SHM_V, pa0, pa1, pa2, pa3);
    if (hi == 0) li_l[r32] = l_reg; asm volatile("s_waitcnt lgkmcnt(0)" ::: "memory");
    if (P.lse != nullptr && hi == 0) P.lse[(long)(wid * QBLK + r32) * P.lse_ld] = m_reg * SCALE + __logf(l_reg);
    float rli[16];
#pragma unroll
    for (int r = 0; r < 16; ++r) rli[r] = __builtin_amdgcn_rcpf(li_l[crow(r, hi)]);
    __syncthreads();
    {
        char* st = lds + wid * 10240;
        const bool odd = (r32 & 1) != 0;
        const int sbase = (crow(0, hi) + (odd ? 1 : 0)) * 320 + (r32 & ~1) * 2;
#pragma unroll
        for (int d0 = 0; d0 < 4; ++d0)
#pragma unroll
            for (int rp = 0; rp < 8; ++rp) { const int r = 2 * rp;
                const float a = o[d0][r] * rli[r], b = o[d0][r + 1] * rli[r + 1];
                const float t = odd ? a : b; const float rcv = dpp_xor1(t);
                const unsigned w = odd ? cvt_pk_bf16(rcv, b) : cvt_pk_bf16(a, rcv);
                *(unsigned*)(st + sbase + (crow(r, 0)) * 320 + d0 * 64) = w; }
        asm volatile("s_waitcnt lgkmcnt(0)" ::: "memory");
        bf16_t* Ow = P.O + (long)(wid * QBLK) * P.ldo;
#pragma unroll
        for (int i = 0; i < 8; ++i) { const int chunk = i * 64 + lane, row = chunk >> 4, c16 = chunk & 15;
            const u32x4 v = *(const u32x4*)(st + row * 320 + c16 * 16);
            *(u32x4*)(Ow + (long)row * P.ldo + c16 * 8) = v; }
    }
#undef SLOAD
#undef SWRITE
#undef SWAIT
#undef RESC
}

constexpr int B_V = 0, B_K = 65536, B_WS = 98304, B_QL = 100352, B_LUT = 133120;
template <int MODE, int VW>
__device__ __forceinline__ void attn_unit_s(const AttnP& P, char* lds, const int tid) {
    const int wid = __builtin_amdgcn_readfirstlane(tid >> 6), lane = tid & 63, r32 = lane & 31, hi = lane >> 5;
    char* V_lds = lds + B_V; char* K_lds = lds + B_K;
    float* ws = (float*)(lds + B_WS) + wid * 64; float* li_l = ws; float* al_l = ws + 32;
    const LAS float* lut = (const LAS float*)((LAS char*)lds + B_LUT);
    __syncthreads();
    if constexpr (MODE != 0) { for (int i = tid; i < P.lut_n; i += NTHREADS) ((LAS float*)lut)[i] = P.lut[i]; }
    ModeCtx mc; mc.rs = mc.cs = mc.qi = mc.qj = 0; mc.krow0 = P.krow0; mc.far_thr = P.far_thr; mc.qlo = P.q0abs + wid * QBLK; mc.cpos = 0.f; mc.cneg = 0.f;
    mc.lidx = P.lbase - (wid * QBLK + r32) + 4 * hi;
    if constexpr (MODE == 3) { const int tq = P.qtok0 + wid * QBLK + r32; mc.qi = tq >> 6; mc.qj = tq & 63; mc.rs = min(max(mc.qi - 4, 0), 56); mc.cs = min(max(mc.qj - 8, 0), 48); }
    int t_lo = 0, t_hi = P.NT;
    if constexpr (MODE == 1) { if (P.far_thr >= (1 << 20)) { const int qlo = 512 - P.lbase + wid * QBLK; t_lo = max(0, (qlo - 64) >> 6); t_hi = min(P.NT, ((qlo + 31 + 64) >> 6) + 1); } }
    if constexpr (MODE == 3) { const int qi0 = (P.qtok0 + wid * QBLK) >> 6, rs0 = min(max(qi0 - 4, 0), 56); t_lo = rs0 - P.krow0; t_hi = t_lo + 8; }
    constexpr bool QLD = (VW == 2);
    float m_reg = -1e30f, l_reg = 0; f32x16 o[4 * VW] = {}; bf16x8 qr[QLD ? 4 : 8];
    const LAS char* qlds = (const LAS char*)lds + B_QL + wid * 4096 + lane * 16;
    const bf16_t* Qw = P.Q + (long)(wid * QBLK + r32) * P.ldq + hi * 8;
#pragma unroll
    for (int d0 = 0; d0 < 8; ++d0) { const bf16x8 qv = *reinterpret_cast<const bf16x8*>(Qw + d0 * 16);
        if (QLD && d0 >= 4) *(LAS bf16x8*)((LAS char*)qlds + (d0 - 4) * 1024) = qv; else qr[d0 < (QLD ? 4 : 8) ? d0 : 0] = qv; }
    const int vb0 = (int)(uintptr_t)V_lds + v_rd_base(lane);
    const long LDK = P.ldk;
    unsigned offK[2], offV[2];
#pragma unroll
    for (int i = 0; i < 2; ++i) { const int sl = tid + 512 * i, row = sl >> 4, ch = (sl & 15) ^ (row & 7); offK[i] = (unsigned)((row * LDK + ch * 8) * 2); }
#pragma unroll
    for (int i = 0; i < 2; ++i) { const int sl = tid + 512 * i, sub = sl >> 5, rowk = (sl >> 2) & 7, cch = sl & 3, kk = (sub >> 2) * 8 + rowk;
        const int k = (kk & ~0xC) | ((kk & 4) << 1) | ((kk & 8) >> 1), col = (sub & 3) * 32 + cch * 8; offV[i] = (unsigned)((k * LDK + col) * 2); }
    LAS unsigned char* ldsw = (LAS unsigned char*)lds + wid * 1024;
#define BDMA(b, k0) do { const char* kb_ = (const char*)P.K + (size_t)(k0) * (size_t)LDK * 2; const char* vp_ = (const char*)P.V + (size_t)(k0) * (size_t)LDK * 2; \
    _Pragma("unroll") for (int _i = 0; _i < 2; ++_i) __builtin_amdgcn_global_load_lds((const unsigned*)(kb_ + offK[_i]), (LAS unsigned*)(ldsw + B_K + (b) * SHM_K + _i * 8192), 16, 0, 0); \
    _Pragma("unroll") for (int _i = 0; _i < 2 * VW; ++_i) __builtin_amdgcn_global_load_lds((const unsigned*)(vp_ + (_i >> 1) * 256 + offV[_i & 1]), (LAS unsigned*)(ldsw + B_V + (b) * 32768 + (_i >> 1) * 16384 + (_i & 1) * 8192), 16, 0, 0); } while (0)
    BDMA(0, 0); asm volatile("s_waitcnt vmcnt(0)" ::: "memory"); __syncthreads();
    if constexpr (MODE == 1) if (P.far_thr < (1 << 20)) { mc.cpos = __uint_as_float(__builtin_amdgcn_readfirstlane(__float_as_uint(lut[P.cidx + P.far_thr]))); mc.cneg = __uint_as_float(__builtin_amdgcn_readfirstlane(__float_as_uint(lut[P.cidx - P.far_thr]))); }
    const int NT = P.NT;
    for (int j = 0; j < NT; ++j) {
        const int b = j & 1;
        if (j + 1 < NT) BDMA(b ^ 1, (j + 1) * KVBLK);
        if (j >= t_lo && j < t_hi) {
        f32x16 p0, p1; float mn, alpha; bf16x8 pa0, pa1, pa2, pa3;
        SBAR(); qkt<QLD>(p0, p1, K_lds + b * SHM_K, qr, qlds, r32, hi);
        const float cb_ = apply_mode<MODE>(p0, p1, j, mc, lut, hi); partialSM(p0, p1, m_reg, mn, alpha, cb_);
        if (__any(alpha < 1.f)) { if (hi == 0) al_l[r32] = alpha; asm volatile("s_waitcnt lgkmcnt(0)" ::: "memory");
#pragma unroll
            for (int d = 0; d < 4 * VW; ++d)
#pragma unroll
                for (int r = 0; r < 16; ++r) o[d][r] *= al_l[crow(r, hi)]; }
        finishSM(p0, p1, alpha, l_reg, pa0, pa1, pa2, pa3); SBAR();
        pv_d0(o, vb0 + b * 32768, pa0, pa1, pa2, pa3); if constexpr (VW == 2) pv_d0(o + 4, vb0 + b * 32768 + 16384, pa0, pa1, pa2, pa3);
        }
        asm volatile("s_waitcnt vmcnt(0)" ::: "memory");
        __syncthreads();
    }
    if (hi == 0) li_l[r32] = l_reg; asm volatile("s_waitcnt lgkmcnt(0)" ::: "memory");
    if (P.lse != nullptr && hi == 0) P.lse[(long)(wid * QBLK + r32) * P.lse_ld] = m_reg * SCALE + __logf(l_reg);
    float rli[16];
#pragma unroll
    for (int r = 0; r < 16; ++r) rli[r] = __builtin_amdgcn_rcpf(li_l[crow(r, hi)]);
    {
        char* st = lds + wid * 10240;
        const bool odd = (r32 & 1) != 0;
        const int sbase = (crow(0, hi) + (odd ? 1 : 0)) * 320 + (r32 & ~1) * 2;
        bf16_t* Ow = P.O + (long)(wid * QBLK) * P.ldo;
#pragma unroll
        for (int hv = 0; hv < VW; ++hv) {
#pragma unroll
            for (int d0 = 0; d0 < 4; ++d0)
#pragma unroll
                for (int rp = 0; rp < 8; ++rp) { const int r = 2 * rp;
                    const float a = o[hv * 4 + d0][r] * rli[r], bb = o[hv * 4 + d0][r + 1] * rli[r + 1];
                    const float t = odd ? a : bb; const float rcv = dpp_xor1(t);
                    const unsigned w = odd ? cvt_pk_bf16(rcv, bb) : cvt_pk_bf16(a, rcv);
                    *(unsigned*)(st + sbase + (crow(r, 0)) * 320 + d0 * 64) = w; }
            asm volatile("s_waitcnt lgkmcnt(0)" ::: "memory");
#pragma unroll
            for (int i = 0; i < 8; ++i) { const int chunk = i * 64 + lane, row = chunk >> 4, c16 = chunk & 15;
                const u32x4 v = *(const u32x4*)(st + row * 320 + c16 * 16);
                *(u32x4*)(Ow + (long)row * P.ldo + hv * 128 + c16 * 8) = v; }
            asm volatile("s_waitcnt lgkmcnt(0)" ::: "memory");
        }
    }
#undef BDMA
}
}

#define XB_TMO      128
#define XB_XCNT(j)  (256  + 64 * (j))
#define XB_XSUB(j)  (1280 + 64 * (j))
#define XB_XGEN(j)  (2304 + 64 * (j))
#define XB_TOP      3328
#define XB_TOPGEN   3392
#define XCD_BAR_WORDS 3456
#define XB_SPIN_CAP (1u << 22)
__device__ __forceinline__ unsigned xb_ld(unsigned* p)              { return __hip_atomic_load(p, __ATOMIC_RELAXED, __HIP_MEMORY_SCOPE_AGENT); }
__device__ __forceinline__ unsigned xb_add(unsigned* p, unsigned v) { return __hip_atomic_fetch_add(p, v, __ATOMIC_RELAXED, __HIP_MEMORY_SCOPE_AGENT); }
__device__ __forceinline__ unsigned xb_xcc_id() { return (unsigned)__builtin_amdgcn_s_getreg((3 << 11) | 20) & 0xFu; }
#define XB_SPIN(cond, bar) do { unsigned _sp = 0; while (cond) { __builtin_amdgcn_s_sleep(1); \
    if ((++_sp & 255u) == 0u) { if (xb_ld(&(bar)[XB_TMO])) break; if (_sp > XB_SPIN_CAP) { atomicAdd(&(bar)[XB_TMO], 1u); break; } } } } while (0)
__device__ __forceinline__ void xcd_barrier_complete(unsigned* bar, unsigned x, unsigned G, unsigned& nloc, unsigned& nx) {
    unsigned sum, cnt, mine, sp = 0u;
    for (;;) {
        sum = 0u; cnt = 0u; mine = 0u;
#pragma unroll
        for (unsigned j = 0; j < 16; ++j) { const unsigned c = xb_ld(&bar[XB_XCNT(j)]); sum += c; cnt += (c > 0u) ? 1u : 0u; mine = (j == x) ? c : mine; }
        if (sum == G) break;
        __builtin_amdgcn_s_sleep(1);
        if ((++sp & 255u) == 0u) { if (xb_ld(&bar[XB_TMO])) break; if (sp > XB_SPIN_CAP) { atomicAdd(&bar[XB_TMO], 1u); break; } }
    }
    nloc = mine > 0u ? mine : 1u; nx = cnt > 0u ? cnt : 1u;
}
__device__ __forceinline__ void xcd_barrier(unsigned* bar, unsigned x, volatile LAS unsigned* st, unsigned G, int tid) {
    asm volatile("s_waitcnt vmcnt(0)" ::: "memory");
    __syncthreads();
    if (tid == 0) {
        __builtin_amdgcn_s_waitcnt(0);
        unsigned nloc = st[0], nx = st[1];
        if (nloc == 0u) { xcd_barrier_complete(bar, x, G, nloc, nx); st[0] = nloc; st[1] = nx; }
        const unsigned old = xb_add(&bar[XB_XSUB(x)], 1u);
        const unsigned gen = old / nloc;
        if (old + 1u == (gen + 1u) * nloc) {
            __builtin_amdgcn_fence(__ATOMIC_RELEASE, "agent");
            asm volatile("s_waitcnt vmcnt(0)" ::: "memory");
            const unsigned og = xb_add(&bar[XB_TOP], 1u);
            const unsigned tg = og / nx;
            if (og + 1u == (tg + 1u) * nx) xb_add(&bar[XB_TOPGEN], 1u);
            else XB_SPIN(xb_ld(&bar[XB_TOPGEN]) == tg, bar);
            __builtin_amdgcn_fence(__ATOMIC_ACQUIRE, "agent");
            xb_add(&bar[XB_XGEN(x)], 1u);
            asm volatile("s_waitcnt vmcnt(0)" ::: "memory");
        } else {
            XB_SPIN(xb_ld(&bar[XB_XGEN(x)]) == gen, bar);
            __builtin_amdgcn_fence(__ATOMIC_ACQUIRE, "agent");
            asm volatile("s_waitcnt vmcnt(0)" ::: "memory");
        }
    }
    __syncthreads();
}

struct Args { const float* in[21]; float* out; unsigned char* ws; int ph_lo, ph_hi; };

struct TrItem { f32x4 v[8]; float gv[8]; };
__device__ __forceinline__ void tr_load(TrItem& t, gfp W, int N, gfp gain, int item, int lane) {
    const int nblk = N / 32, kb = item / nblk, nb = item % nblk, k0 = 64 * kb, n0 = 32 * nb, r8 = lane >> 3, c4 = lane & 7;
    const GAS f32x4* src = (const GAS f32x4*)(W + (size_t)(k0 + r8) * N + n0) + c4;
#pragma unroll
    for (int i = 0; i < 8; ++i) t.v[i] = src[(size_t)i * 2 * N];
#pragma unroll
    for (int i = 0; i < 8; ++i) t.gv[i] = gain ? gain[k0 + 8 * i + r8] : 1.0f;
}
__device__ __forceinline__ void tr_store(const TrItem& t, int K, int N, bf16_t* WT, LAS float* scr, int item, int lane, bool ffn_perm) {
    const int nblk = N / 32, kb = item / nblk, nb = item % nblk, k0 = 64 * kb, n0 = 32 * nb, r8 = lane >> 3, c4 = lane & 7;
    int d0 = n0; if (ffn_perm) { const int bj = n0 / DFF, ff = n0 % DFF; d0 = 256 * (ff >> 7) + 128 * bj + (ff & 127); }
#pragma unroll
    for (int i = 0; i < 8; ++i) { LAS float* d = scr + (8 * i + r8) * 33 + 4 * c4; const f32x4 x = t.v[i] * t.gv[i]; d[0] = x[0]; d[1] = x[1]; d[2] = x[2]; d[3] = x[3]; }
    LDS_WAIT(); asm volatile("" ::: "memory");
    const int c = lane & 7;
#pragma unroll
    for (int j = 0; j < 4; ++j) { const int n = (lane >> 3) + 8 * j; const LAS float* s = scr + (8 * c) * 33 + n;
        u32x4 o; o.x = cvt_pk_bf16(s[0 * 33], s[1 * 33]); o.y = cvt_pk_bf16(s[2 * 33], s[3 * 33]); o.z = cvt_pk_bf16(s[4 * 33], s[5 * 33]); o.w = cvt_pk_bf16(s[6 * 33], s[7 * 33]);
        *(u32x4*)(WT + (size_t)(d0 + n) * K + k0 + 8 * c) = o; }
    LDS_WAIT(); asm volatile("" ::: "memory");
}
__device__ __forceinline__ void transpose_weight(gfp W, int K, int N, bf16_t* WT, gfp gain, LAS float* scr, int gw, int ngw, int lane, bool ffn_perm = false) {
    const int nitems = (K / 64) * (N / 32);
    if (gw >= nitems) return;
    TrItem a, b;
    tr_load(a, W, N, gain, gw, lane);
    for (int it = gw; it < nitems; it += 2 * ngw) {
        const int it1 = it + ngw, it2 = it + 2 * ngw;
        if (it1 < nitems) tr_load(b, W, N, gain, it1, lane);
        tr_store(a, K, N, WT, scr, it, lane, ffn_perm);
        if (it1 < nitems) { if (it2 < nitems) tr_load(a, W, N, gain, it2, lane); tr_store(b, K, N, WT, scr, it1, lane, ffn_perm); }
    }
}
__device__ __forceinline__ int t5_bucket(int rel) {
    const int n = rel < 0 ? -rel : rel; int b;
    if (n < 8) b = n; else if (n <= 14) b = 8; else if (n <= 26) b = 9; else if (n <= 49) b = 10; else if (n <= 90) b = 11;
    else if (n <= 165) b = 12; else if (n <= 304) b = 13; else if (n <= 558) b = 14; else b = 15;
    return b + (rel > 0 ? 16 : 0);
}
__device__ __forceinline__ void conv_fixup_tile(bf16_t* ACT, const float* EG, const float* EU, gfp cw, gfp cb, int pm, int tid) {
    constexpr int F4 = DFF / 4, NIT = 2 * F4;
    for (int it = tid; it < NIT; it += NTHREADS) {
        const int rem = it, e = rem / F4, f = (rem % F4) * 4;
        const f32x4 z = (f32x4){0.f, 0.f, 0.f, 0.f};
        f32x4 up, mid, dn, uu; int row;
        if (e == 0) { up = (pm & 15) == 0 ? z : *(const f32x4*)(EG + ((size_t)(pm - 1) * 4 + 3) * DFF + f); mid = *(const f32x4*)(EG + ((size_t)pm * 4 + 0) * DFF + f);
            dn = *(const f32x4*)(EG + ((size_t)pm * 4 + 1) * DFF + f); uu = *(const f32x4*)(EU + ((size_t)pm * 2 + 0) * DFF + f); row = pm * 256; }
        else { up = *(const f32x4*)(EG + ((size_t)pm * 4 + 2) * DFF + f); mid = *(const f32x4*)(EG + ((size_t)pm * 4 + 3) * DFF + f);
            dn = (pm & 15) == 15 ? z : *(const f32x4*)(EG + ((size_t)(pm + 1) * 4 + 0) * DFF + f); uu = *(const f32x4*)(EU + ((size_t)pm * 2 + 1) * DFF + f); row = pm * 256 + 255; }
        const f32x4 w0 = *(const GAS f32x4*)(cw + f), w1 = *(const GAS f32x4*)(cw + DFF + f), w2 = *(const GAS f32x4*)(cw + 2 * DFF + f), bb = *(const GAS f32x4*)(cb + f);
        const f32x4 a = w0 * up + w1 * mid + w2 * dn + bb;
        u32x2 ow; ow.x = cvt_pk_bf16(gelu_tanh(a[0]) * uu[0], gelu_tanh(a[1]) * uu[1]); ow.y = cvt_pk_bf16(gelu_tanh(a[2]) * uu[2], gelu_tanh(a[3]) * uu[3]);
        *(u32x2*)(ACT + (size_t)row * DFF + f) = ow;
    }
}

__global__ void __launch_bounds__(NTHREADS, 2) mk_fwd(Args args) {
    extern __shared__ __attribute__((aligned(16))) unsigned char lds[];
    const int wave0 = __builtin_amdgcn_readfirstlane((int)(threadIdx.x >> 6));
    const int G = gridDim.x, bx = blockIdx.x, ngw = G * NWAVES;
    const int vcu = (G % 8 == 0) ? (bx % 8) * (G / 8) + bx / 8 : bx;
#define PH_IDS const int tid = ltid(), lane = tid & 63, wave = __builtin_amdgcn_readfirstlane(tid >> 6), gw = bx * NWAVES + wave; LAS float* scr = (LAS float*)(ldsl + wave * 8704); (void)lane; (void)gw; (void)scr;
    unsigned char* ws = args.ws;
    const float* const* tab = (const float* const*)(ws + WS_TAB);
#define TAB(i) uni_ptr((gfp)__builtin_nontemporal_load(&tab[i]))
    float* H = args.out;
    float* ss = (float*)(ws + WS_SS);
    float* lse = (float*)(ws + WS_LSE);
    float* lut1 = (float*)(ws + WS_LUT1); float* lut2 = (float*)(ws + WS_LUT2); float* lut3 = (float*)(ws + WS_LUT3);
    bf16_t* Win = (bf16_t*)(ws + WS_WIN); bf16_t* Wout0 = (bf16_t*)(ws + WS_WOUT); bf16_t* Wout1 = (bf16_t*)(ws + WS_WIN + 18 * MiB);
    bf16_t* Wup = (bf16_t*)(ws + WS_WUP); bf16_t* Wdn = (bf16_t*)(ws + WS_WDN);
    bf16_t* R1 = (bf16_t*)(ws + WS_R1); bf16_t* R2 = (bf16_t*)(ws + WS_R2); bf16_t* BIG = (bf16_t*)(ws + WS_BIG);
    float* EG = (float*)(ws + WS_BIG + 192 * MiB); float* EU = EG + (size_t)64 * 4 * DFF;
    LAS unsigned char* ldsl = (LAS unsigned char*)lds;

    unsigned* barw = (unsigned*)(ws + WS_BAR); const unsigned xcc = xb_xcc_id();
    volatile LAS unsigned* bst = (volatile LAS unsigned*)(ldsl + LDS_BYTES - 64);
    { const int t0 = ltid(); if (t0 < 2) bst[t0] = 0u; if (t0 == 0) (void)xb_add(&barw[XB_XCNT(xcc)], 1u); }
    __syncthreads();
    const int lo = args.ph_lo, hi_ph = args.ph_hi;
#ifndef REP_MASK
#define REP_MASK 0
#endif
#define REPS(k) (((REP_MASK >> (k)) & 1) ? 2 : 1)
#ifndef PH_MASK
#define PH_MASK 0xffff
#endif
#define IN(k) (((PH_MASK >> (k)) & 1) && lo <= (k) && (k) < hi_ph)
#define SEAM2(a, b) do { if (IN(a) && IN(b)) { xcd_barrier(barw, xcc, bst, (unsigned)G, ltid()); } } while (0)
#define SEAM(k) SEAM2(k, (k) + 1)

    if (IN(0)) {
        PH_IDS
        gfp x = (gfp)args.in[0]; gfp ln_mix = (gfp)args.in[1]; gfp ln_ffn = (gfp)args.in[2]; gfp t5 = (gfp)args.in[4];
        gfp ev_w_in = (gfp)args.in[5]; gfp ev_w_out = (gfp)args.in[6]; gfp rpb = (gfp)args.in[16]; gfp w_up = (gfp)args.in[17]; gfp w_down = (gfp)args.in[20];
        if (bx == 0 && tid < 21) ((const float**)(ws + WS_TAB))[tid] = args.in[tid];
        if (bx == 0 && tid == 0) *(unsigned long long*)(ws + WS_TAB + 512) = *(const unsigned long long*)((const char*)__builtin_amdgcn_implicitarg_ptr() + 0x58);
        transpose_weight(ev_w_in, DM, EV_IN, Win, ln_mix, scr, gw, ngw, lane);
        for (int row = gw; row < MT; row += ngw) {
            const GAS f32x4* xr = (const GAS f32x4*)(x + (size_t)row * DM) + lane; u32x2* xo = (u32x2*)(R1 + (size_t)row * DM) + lane;
            float s = 0.f; f32x4 xv[8];
#pragma unroll
            for (int j = 0; j < 8; ++j) { xv[j] = xr[64 * j]; s += (xv[j][0] * xv[j][0] + xv[j][1] * xv[j][1]) + (xv[j][2] * xv[j][2] + xv[j][3] * xv[j][3]); }
            s = wave_sum(s);
            const float rs0 = __builtin_amdgcn_rsqf(s * (1.0f / DM) + RMS_EPS);
#pragma unroll
            for (int j = 0; j < 8; ++j) { const f32x4 v = xv[j] * rs0; u32x2 w; w.x = cvt_pk_bf16(v[0], v[1]); w.y = cvt_pk_bf16(v[2], v[3]); xo[64 * j] = w; }
            if (lane == 0) ss[row] = s;
        }
        for (int i = bx * NTHREADS + tid; i < 4 * MT; i += G * NTHREADS) ss[MT + i] = 0.f;
        const float inv_scale = 1.0f / ATT_SCALE;
        for (int i = bx * NTHREADS + tid; i < 4 * 2304; i += G * NTHREADS) { const int h = i / 2304, idx = i % 2304; const int rel = idx - 1024;
            lut1[i] = (idx <= 2048) ? t5[t5_bucket(rel) * 28 + 24 + h] * inv_scale : 0.f; }
        for (int i = bx * NTHREADS + tid; i < 24 * 1024; i += G * NTHREADS) { const int gh = i >> 10, idx = i & 1023, j = idx - 512, g = gh >> 3; const int dil = 1 << (2 * g);
            lut2[i] = (j >= -64 && j <= 64) ? t5[t5_bucket(dil * j) * 28 + gh] * inv_scale : -INFINITY; }
        for (int i = bx * NTHREADS + tid; i < 8 * 512; i += G * NTHREADS) { const int h = i >> 9, idx = i & 511;
            lut3[i] = (idx < 465) ? rpb[h * 465 + idx] * inv_scale : 0.f; }
    }
    SEAM(0);
    if (IN(1)) {
        pg8::Gemm g{R1, Win, MT, EV_IN, DM, DM}; pg8::StaticOrder S; S.init(MT, EV_IN, G, bx);
        pg8::EpiScaleBf16<false> E{BIG, EV_LD, ss, (LAS float*)(ldsl + 135168)};
        pg8::gemm_phase<pg8::EpiScaleBf16<false>, pg8::StaticOrder>(ldsl, g, S, E, ltid());
    }
    SEAM(1);
    if (IN(2)) {
        constexpr int NB_UNITS = 512, NA_UNITS = 1536;
        const int wslot2 = vcu & 7; int ucnt2 = 0;
#define P2_WEIGHTS() do { if (ucnt2++ == wslot2) { __syncthreads(); PH_IDS gfp ev_w_out = TAB(6); gfp w_up = TAB(17); gfp w_down = TAB(20); gfp ln_ffn = TAB(2); gfp od_w_in = TAB(12); gfp od_w_out = TAB(13); gfp ln_mix = TAB(1); \
            transpose_weight(ev_w_out, DM, DM, Wout0, nullptr, scr, gw, ngw, lane); transpose_weight(w_up, DM, DFF2, Wup, ln_ffn, scr, gw, ngw, lane, true); \
            transpose_weight(w_down, DFF, DM, Wdn, nullptr, scr, gw, ngw, lane); \
            transpose_weight(od_w_in, DM, OD_IN, Win, ln_mix + DM, scr, gw, ngw, lane); transpose_weight(od_w_out, DM, DM, Wout1, nullptr, scr, gw, ngw, lane); __syncthreads(); } } while (0)
        for (int idx = vcu; idx < NB_UNITS; idx += G) {
            att::AttnP P;
            {
                const int qblk = idx & 15, rest = idx >> 4, mp = rest & 1, h = (rest >> 1) & 3, b = rest >> 3;
                const bf16_t* base = BIG + (size_t)b * SEQ * EV_LD;
                P.Q = base + (size_t)(qblk * 256) * EV_LD + 9216 + h * 256 + mp * 128;
                P.K = base + 10240 + h * 256 + mp * 128; P.V = base + 11264 + h * 256;
                P.O = R2 + ((size_t)mp * MT + (size_t)b * SEQ + qblk * 256) * 1024 + h * 256;
                P.lse = nullptr; P.ldq = EV_LD; P.ldk = EV_LD; P.ldo = 1024; P.lse_ld = 0; P.NT = SEQ / 64;
                P.lut = lut1 + h * 2304; P.lut_n = 2304; P.lbase = 1024 - qblk * 256; P.krow0 = 0; P.qtok0 = 0; P.far_thr = 559; P.q0abs = qblk * 256; P.cidx = 1024;
                att::attn_unit_s<1, 2>(P, (char*)lds, ltid());
                P2_WEIGHTS();
            }
        }
        for (int i2 = vcu; i2 < NA_UNITS; i2 += G) {
            att::AttnP P;
            {
                const int sub = i2 & 15, rest = i2 >> 4, h = rest & 7, b = (rest >> 3) & 3, g = rest >> 5;
                const int dil = 1 << (2 * g), upc = 16 >> (2 * g), r = sub / upc, u = sub % upc, ntseg = (SEQ / dil) / 64;
                const int q0 = u * 256;
                int tb = q0 / 64 - 1; if (tb < 0) tb = 0; int te = q0 / 64 + 5; if (te > ntseg) te = ntseg;
                if ((te - tb) & 1) { if (tb > 0) --tb; else ++te; }
                const long ld = (long)dil * EV_LD;
                const bf16_t* base = BIG + ((size_t)b * SEQ + r) * EV_LD + g * 3072 + h * 128;
                P.Q = base + (size_t)q0 * ld; P.K = base + 1024 + (size_t)(tb * 64) * ld; P.V = base + 2048 + (size_t)(tb * 64) * ld;
                P.O = (bf16_t*)P.Q; P.ldq = ld; P.ldk = ld; P.ldo = ld;
                P.lse = lse + ((size_t)g * MT + (size_t)b * SEQ + r + (size_t)q0 * dil) * 8 + h; P.lse_ld = 8 * dil;
                P.NT = te - tb; P.lut = lut2 + (g * 8 + h) * 1024; P.lut_n = 1024; P.lbase = 512 - (q0 - tb * 64); P.krow0 = 0; P.qtok0 = 0; P.far_thr = 1 << 30; P.q0abs = 0; P.cidx = 0;
            }
            att::attn_unit_s<1, 1>(P, (char*)lds, ltid());
            P2_WEIGHTS();
        }
        while (ucnt2 <= wslot2) P2_WEIGHTS();
#undef P2_WEIGHTS
    }
    SEAM(2);
    if (IN(3)) {
        PH_IDS
        gfp lq1 = TAB(7); gfp lk1 = TAB(8); gfp lq2 = TAB(9); gfp lk2 = TAB(10); gfp subln = TAB(11);
        const f32x4 sl0 = *(const GAS f32x4*)(subln + (lane & 31) * 8), sl1 = *(const GAS f32x4*)(subln + (lane & 31) * 8 + 4);
        float a1 = lq1[lane] * lk1[lane] + lq1[lane + 64] * lk1[lane + 64], a2 = lq2[lane] * lk2[lane] + lq2[lane + 64] * lk2[lane + 64];
        a1 = wave_sum(a1); a2 = wave_sum(a2);
        const float lam = __expf(a1) - __expf(a2) + 0.2f;
        for (int row = gw; row < MT; row += ngw) {
            const bf16_t* pr = BIG + (size_t)row * EV_LD; bf16_t* mo = R1 + (size_t)row * DM;
#pragma unroll
            for (int j = 0; j < 2; ++j) {
                const int col = j * 512 + lane * 8, h = col >> 7;
                const float l0 = lse[((size_t)0 * MT + row) * 8 + h], l1 = lse[((size_t)1 * MT + row) * 8 + h], l2 = lse[((size_t)2 * MT + row) * 8 + h];
                const float mx = fmaxf(l0, fmaxf(l1, l2)); float e0 = __expf(l0 - mx), e1 = __expf(l1 - mx), e2 = __expf(l2 - mx);
                const float inv = 1.0f / (e0 + e1 + e2); e0 *= inv; e1 *= inv; e2 *= inv;
                const u32x4 o0 = *(const u32x4*)(pr + col), o1 = *(const u32x4*)(pr + 3072 + col), o2 = *(const u32x4*)(pr + 6144 + col);
                u32x4 w;
#pragma unroll
                for (int q = 0; q < 4; ++q) w[q] = cvt_pk_bf16(e0 * bf_lo(o0[q]) + e1 * bf_lo(o1[q]) + e2 * bf_lo(o2[q]), e0 * bf_hi(o0[q]) + e1 * bf_hi(o1[q]) + e2 * bf_hi(o2[q]));
                *(u32x4*)(mo + col) = w;
            }
#pragma unroll
            for (int j = 0; j < 2; ++j) {
                const int col = j * 512 + lane * 8, dv = (lane & 31) * 8;
                const u32x4 p1 = *(const u32x4*)(R2 + (size_t)row * 1024 + col), p2 = *(const u32x4*)(R2 + ((size_t)MT + row) * 1024 + col);
                float v[8]; float s = 0.f;
#pragma unroll
                for (int q = 0; q < 4; ++q) { v[2 * q] = bf_lo(p1[q]) - lam * bf_lo(p2[q]); v[2 * q + 1] = bf_hi(p1[q]) - lam * bf_hi(p2[q]); s += v[2 * q] * v[2 * q] + v[2 * q + 1] * v[2 * q + 1]; }
#pragma unroll
                for (int o = 1; o < 32; o <<= 1) s += __shfl_xor(s, o);
                const float rs = __builtin_amdgcn_rsqf(s * (1.0f / 256.0f) + RMS_EPS) * 0.8f;
                u32x4 w;
#pragma unroll
                for (int q = 0; q < 4; ++q) { const f32x4 sl = q < 2 ? sl0 : sl1; w[q] = cvt_pk_bf16(v[2 * q] * rs * sl[(2 * q) & 3], v[2 * q + 1] * rs * sl[(2 * q + 1) & 3]); }
                *(u32x4*)(mo + 1024 + col) = w;
            }
        }
    }
    SEAM(3);
    if (IN(4)) {
        pg8::Gemm g{R1, Wout0, MT, DM, DM, DM}; pg8::StaticOrder S; S.init(MT, DM, G, bx);
        gfp x = TAB(0);
        pg8::EpiResid<true, false> E{x, nullptr, nullptr, R2, ss + MT};
        pg8::gemm_phase<pg8::EpiResid<true, false>, pg8::StaticOrder>(ldsl, g, S, E, ltid());
    }
    SEAM(4);
    if (IN(5)) {
        pg8::Gemm g{R2, Wup, MT, DFF2, DM, DM}; pg8::StaticOrder S; S.init(MT, DFF2, G, bx);
        gfp conv_w = TAB(18); gfp conv_b = TAB(19);
        pg8::EpiConvGelu E{BIG, ss + MT, conv_w, conv_b, EG, EU, (LAS float*)(ldsl + 131072)};
        pg8::gemm_phase<pg8::EpiConvGelu, pg8::StaticOrder>(ldsl, g, S, E, ltid());
    }
    SEAM2(5, 7);
    if (IN(7)) {
        pg8::Gemm g{BIG, Wdn, MT, DM, DFF, DFF}; pg8::StaticOrder S; S.init(MT, DM, G, bx);
        { PH_IDS gfp conv_w = TAB(18); gfp conv_b = TAB(19); pg8::Unit u0; int lastpm = -1;
          for (int i = 0; S.next(i, u0); ++i) if (u0.pm != lastpm) { conv_fixup_tile(BIG, EG, EU, conv_w, conv_b, u0.pm, tid); lastpm = u0.pm; }
          asm volatile("s_waitcnt vmcnt(0)" ::: "memory"); __syncthreads(); }
        pg8::EpiResid<false, false> E{nullptr, R2, nullptr, R2, ss + 2 * MT};
        pg8::gemm_phase<pg8::EpiResid<false, false>, pg8::StaticOrder>(ldsl, g, S, E, ltid());
    }
    SEAM(7);
    if (IN(8)) {
        pg8::Gemm g{R2, Win, MT, OD_IN, DM, DM}; pg8::StaticOrder S; S.init(MT, OD_IN, G, bx);
        gfp qnorm = TAB(14); gfp knorm = TAB(15);
        pg8::EpiScaleRope E{BIG, OD_IN, ss + 2 * MT, (LAS float*)(ldsl + 135168), (LAS float*)(ldsl + 131072), qnorm, knorm};
        pg8::gemm_phase<pg8::EpiScaleRope, pg8::StaticOrder>(ldsl, g, S, E, ltid());
    }
    SEAM2(8, 10);
    if (IN(10)) {
        constexpr int NC_UNITS = 512, ND_UNITS = 512;
        const int wslot10 = vcu & 3; int ucnt10 = 0;
#define P10_WEIGHTS() do { if (ucnt10++ == wslot10) { __syncthreads(); PH_IDS gfp w_up = TAB(17); gfp w_down = TAB(20); gfp ln_ffn = TAB(2); \
            transpose_weight(w_up + (size_t)DM * DFF2, DM, DFF2, Wup, ln_ffn + DM, scr, gw, ngw, lane, true); \
            transpose_weight(w_down + (size_t)DFF * DM, DFF, DM, Wdn, nullptr, scr, gw, ngw, lane); __syncthreads(); } } while (0)
        for (int idx = vcu; idx < NC_UNITS; idx += G) {
            att::AttnP P; P.lse = nullptr; P.lse_ld = 0; P.ldq = OD_IN; P.ldk = OD_IN; P.ldo = DM; P.lbase = 0; P.krow0 = 0; P.qtok0 = 0; P.lut = nullptr; P.lut_n = 0; P.far_thr = 1 << 30; P.q0abs = 0; P.cidx = 0;
            {
                const int qblk = idx & 15, hq = (idx >> 4) & 7, b = idx >> 7;
                const bf16_t* base = BIG + (size_t)b * SEQ * OD_IN;
                P.Q = base + (size_t)(qblk * 256) * OD_IN + hq * 128; P.K = base + 1024 + (hq >> 2) * 128; P.V = base + 1280 + (hq >> 2) * 128;
                P.O = R1 + ((size_t)b * SEQ + qblk * 256) * DM + hq * 128; P.NT = SEQ / 64;
                if (ATT_EN & 1) att::attn_unit<0, 2, false>(P, (char*)lds, ltid());
                P10_WEIGHTS();
            }
        }
        for (int i2 = vcu; i2 < ND_UNITS; i2 += G) {
            att::AttnP P; P.lse = nullptr; P.lse_ld = 0; P.ldq = OD_IN; P.ldk = OD_IN; P.ldo = DM; P.lbase = 0; P.krow0 = 0; P.qtok0 = 0; P.lut = nullptr; P.lut_n = 0; P.far_thr = 1 << 30; P.q0abs = 0; P.cidx = 0;
            {
                const int u = i2 & 15, h = (i2 >> 4) & 7, b = i2 >> 7;
                const int krow0 = min(max(4 * u - 4, 0), 56), nt = (u == 0 || u == 15) ? 8 : 12;
                const bf16_t* base = BIG + (size_t)b * SEQ * OD_IN + 1536 + h * 128;
                P.Q = base + (size_t)(u * 256) * OD_IN; P.K = base + 1024 + (size_t)(krow0 * 64) * OD_IN; P.V = base + 2048 + (size_t)(krow0 * 64) * OD_IN;
                P.O = R1 + ((size_t)b * SEQ + u * 256) * DM + 1024 + h * 128; P.NT = nt;
                P.lut = lut3 + h * 512; P.lut_n = 512; P.krow0 = krow0; P.qtok0 = u * 256;
                att::attn_unit_s<3, 1>(P, (char*)lds, ltid());
                P10_WEIGHTS();
            }
        }
        while (ucnt10 <= wslot10) P10_WEIGHTS();
#undef P10_WEIGHTS
    }
    SEAM(10);
    if (IN(11)) {
        pg8::Gemm g{R1, Wout1, MT, DM, DM, DM}; pg8::StaticOrder S; S.init(MT, DM, G, bx);
        pg8::EpiResid<false, false> E{nullptr, R2, nullptr, R2, ss + 3 * MT};
        pg8::gemm_phase<pg8::EpiResid<false, false>, pg8::StaticOrder>(ldsl, g, S, E, ltid());
    }
    SEAM(11);
    if (IN(12)) {
        pg8::Gemm g{R2, Wup, MT, DFF2, DM, DM}; pg8::StaticOrder S; S.init(MT, DFF2, G, bx);
        gfp conv_w = TAB(18); gfp conv_b = TAB(19);
        pg8::EpiConvGelu E{BIG, ss + 3 * MT, conv_w + 3 * DFF, conv_b + DFF, EG, EU, (LAS float*)(ldsl + 131072)};
        pg8::gemm_phase<pg8::EpiConvGelu, pg8::StaticOrder>(ldsl, g, S, E, ltid());
    }
    SEAM2(12, 14);
    if (IN(14)) {
        pg8::Gemm g{BIG, Wdn, MT, DM, DFF, DFF}; pg8::StaticOrder S; S.init(MT, DM, G, bx);
        { PH_IDS gfp conv_w = TAB(18); gfp conv_b = TAB(19); pg8::Unit u0; int lastpm = -1;
          for (int i = 0; S.next(i, u0); ++i) if (u0.pm != lastpm) { conv_fixup_tile(BIG, EG, EU, conv_w + 3 * DFF, conv_b + DFF, u0.pm, tid); lastpm = u0.pm; }
          asm volatile("s_waitcnt vmcnt(0)" ::: "memory"); __syncthreads(); }
        pg8::EpiResid<false, true> E{nullptr, R2, H, nullptr, ss + 4 * MT};
        pg8::gemm_phase<pg8::EpiResid<false, true>, pg8::StaticOrder>(ldsl, g, S, E, ltid());
    }
    SEAM(14);
    if (IN(15)) {
        PH_IDS
        gfp ln_final = TAB(3);
        f32x4 gfin[8];
#pragma unroll
        for (int j = 0; j < 8; ++j) gfin[j] = ((const GAS f32x4*)ln_final)[64 * j + lane];
        for (int row = gw; row < MT; row += ngw) {
            f32x4* hr = (f32x4*)(H + (size_t)row * DM) + lane;
            const float rs = __builtin_amdgcn_rsqf(ss[4 * MT + row] * (1.0f / DM) + RMS_EPS);
            f32x4 hv[8];
#pragma unroll
            for (int j = 0; j < 8; ++j) hv[j] = hr[64 * j];
#pragma unroll
            for (int j = 0; j < 8; ++j) __builtin_nontemporal_store(hv[j] * rs * gfin[j], &hr[64 * j]);
        }
    }
#undef IN
#undef SEAM
}

extern "C" void kernel_launch(void* const* d_in, const int* in_sizes, int n_in, void* d_out, int out_size, void* d_ws, size_t ws_size, hipStream_t stream) {
    static int grid = 0;
    if (grid == 0) {
        if (n_in != 21 || out_size != MT * DM || ws_size < WS_END) { fprintf(stderr, "kernel_launch: unexpected shapes (n_in %d out %d ws %zu, need ws >= %zu)\n", n_in, out_size, ws_size, (size_t)WS_END); grid = -1; return; }
        int dev = 0, cus = 0, per_cu = 0;
        if (hipGetDevice(&dev) != hipSuccess || hipDeviceGetAttribute(&cus, hipDeviceAttributeMultiprocessorCount, dev) != hipSuccess) { grid = -1; return; }
        if (hipFuncSetAttribute((const void*)mk_fwd, hipFuncAttributeMaxDynamicSharedMemorySize, LDS_BYTES) != hipSuccess) { fprintf(stderr, "kernel_launch: hipFuncSetAttribute failed\n"); grid = -1; return; }
        if (hipOccupancyMaxActiveBlocksPerMultiprocessor(&per_cu, (const void*)mk_fwd, NTHREADS, LDS_BYTES) != hipSuccess || per_cu < 1) { fprintf(stderr, "kernel_launch: occupancy query says %d\n", per_cu); per_cu = 1; }
        (void)hipGetLastError();
        grid = cus * per_cu;
    }
    if (grid < 0) return;
    if (hipMemsetAsync((char*)d_ws + WS_BAR, 0, 16384, stream) != hipSuccess) { fprintf(stderr, "kernel_launch: memset failed\n"); return; }
    Args a{};
    for (int i = 0; i < 21; ++i) a.in[i] = (const float*)d_in[i];
    a.out = (float*)d_out; a.ws = (unsigned char*)d_ws;
#if MK_PER_PHASE
    for (int p = 0; p < NPHASES; ++p) { a.ph_lo = p; a.ph_hi = p + 1; hipLaunchKernelGGL(mk_fwd, dim3(grid), dim3(NTHREADS), LDS_BYTES, stream, a); }
#else
    a.ph_lo = 0; a.ph_hi = NPHASES;
    void* kargs[] = {&a};
    hipError_t e = hipLaunchCooperativeKernel((void*)mk_fwd, dim3(grid), dim3(NTHREADS), kargs, LDS_BYTES, stream);
    if (e != hipSuccess) fprintf(stderr, "cooperative launch failed: %s (grid %d)\n", hipGetErrorString(e), grid);
#endif
}
```
